# Optimizing an MI355X kernel written in HIP

```python
import math
import jax, jax.numpy as jnp
from jax import lax
import numpy as np

D_MODEL = 1024
BATCH = 8
SEQ = 4096
DEPTH = 2
DEC_BATCH = 2
DEC_SEQ = 16384
PAST_LEN = 128

HEAD_DIM = 128
N_HEADS_A = 8
N_KV_A = 2
N_HEADS_B = 8
N_KV_B = 2
WINDOW = 128
BLOCK = 128
N_POOL_GROUPS = 4
POOL_WINDOWS = (2, 4, 8, 16)
POOL_GROUP_DIM = D_MODEL // N_POOL_GROUPS
N_BRANCHES = 3
N_META = 16
GRID_W = 64
ROPE_THETA = 10000.0
D_FF = -(-8 * D_MODEL // (3 * 256)) * 256
ALPHA = (2 * DEPTH) ** 0.25
BETA = (8 * DEPTH) ** -0.25
NEG = -1e30
IN_WIDTHS = (N_HEADS_A * HEAD_DIM, N_KV_A * HEAD_DIM, N_KV_A * HEAD_DIM,
             N_HEADS_B * HEAD_DIM, N_KV_B * HEAD_DIM, N_KV_B * HEAD_DIM,
             D_MODEL, N_BRANCHES * D_MODEL)
IN_WIDTH = sum(IN_WIDTHS)

kernel_name = "hybrid_gated_bidir_encoder"


def _layer_norm(x, g, b, eps=1e-5):
    xf = x.astype(jnp.float32)
    mu = jnp.mean(xf, -1, keepdims=True)
    var = jnp.mean(jnp.square(xf - mu), -1, keepdims=True)
    y = (xf - mu) * lax.rsqrt(var + eps) * g.astype(jnp.float32) + b.astype(jnp.float32)
    return y.astype(x.dtype)


def _rms_norm(x, g, eps=1e-6):
    xf = x.astype(jnp.float32)
    y = xf * lax.rsqrt(jnp.mean(xf * xf, -1, keepdims=True) + eps) * g.astype(jnp.float32)
    return y.astype(x.dtype)


def _rope(x, pos, dim):
    inv = ROPE_THETA ** (-jnp.arange(0, dim, 2, dtype=jnp.float32) / dim)
    ang = pos.astype(jnp.float32)[:, None] * inv[None, :]
    cos = jnp.cos(ang)[:, None, :]
    sin = jnp.sin(ang)[:, None, :]
    xf = x.astype(jnp.float32)
    x1, x2 = xf[..., : dim // 2], xf[..., dim // 2:]
    return jnp.concatenate([x1 * cos - x2 * sin, x1 * sin + x2 * cos], -1).astype(x.dtype)


def _axial_rope(x, row, col):
    half = HEAD_DIM // 2
    return jnp.concatenate([_rope(x[..., :half], row, half), _rope(x[..., half:], col, half)], -1)


def _sink_softmax(s, sink):
    m = jnp.maximum(jnp.max(s, -1, keepdims=True), sink)
    e = jnp.exp(s - m)
    return e / (jnp.sum(e, -1, keepdims=True) + jnp.exp(sink - m))


def _dense_attend(q, k, v):
    s = jnp.einsum('bqkgd,bskd->bkgqs', q, k).astype(jnp.float32) * HEAD_DIM ** -0.5
    p = jax.nn.softmax(s, axis=-1).astype(v.dtype)
    return jnp.einsum('bkgqs,bskd->bqkgd', p, v)


def _mixer_global(q, k, v, q_g, k_g):
    B, L = q.shape[:2]
    S = L - N_META
    nb = S // BLOCK
    ROWS = S // GRID_W
    row = jnp.concatenate([-jnp.ones((N_META,), jnp.int32), jnp.repeat(jnp.arange(ROWS, dtype=jnp.int32), GRID_W)])
    col = jnp.concatenate([jnp.arange(N_META, dtype=jnp.int32), jnp.tile(jnp.arange(GRID_W, dtype=jnp.int32), ROWS)])
    q = _axial_rope(_rms_norm(q, q_g), row, col)
    k = _axial_rope(_rms_norm(k, k_g), row, col)
    g = N_HEADS_A // N_KV_A
    q = q.reshape(B, L, N_KV_A, g, HEAD_DIM)
    o_meta = _dense_attend(q[:, :N_META], k, v)
    qb = jnp.moveaxis(q[:, N_META:].reshape(B, nb, BLOCK, N_KV_A, g, HEAD_DIM), 1, 0)
    o_real = lax.map(lambda qi: _dense_attend(qi, k, v), qb)
    o_real = jnp.moveaxis(o_real, 0, 1).reshape(B, S, N_KV_A, g, HEAD_DIM)
    return jnp.concatenate([o_meta, o_real], 1).reshape(B, L, N_HEADS_A * HEAD_DIM)


def _band(t, B, nb):
    tb = t[:, N_META:].reshape(B, nb, BLOCK, t.shape[2], t.shape[3])
    tp = jnp.pad(tb, ((0, 0), (1, 1), (0, 0), (0, 0), (0, 0)))
    return jnp.concatenate([tp[:, :-2], tp[:, 1:-1], tp[:, 2:]], axis=2)


def _mixer_window(q, k, v, sink):
    B, L = q.shape[:2]
    S = L - N_META
    nb = S // BLOCK
    pos = jnp.arange(L)
    q = _rope(q, pos, HEAD_DIM)
    k = _rope(k, pos, HEAD_DIM)
    g = N_HEADS_B // N_KV_B
    q = q.reshape(B, L, N_KV_B, g, HEAD_DIM)
    scale = HEAD_DIM ** -0.5
    sink_f = sink.astype(jnp.float32).reshape(N_KV_B, g)
    k_meta, v_meta = k[:, :N_META], v[:, :N_META]

    n_front = N_META + BLOCK
    s = jnp.einsum('bqkgd,bskd->bkgqs', q[:, :N_META], k[:, :n_front]).astype(jnp.float32) * scale
    qi = jnp.arange(N_META)[:, None]
    kj = jnp.arange(n_front)[None, :]
    s = jnp.where((kj < N_META) | (kj - qi <= WINDOW), s, NEG)
    p = _sink_softmax(s, sink_f[None, :, :, None, None]).astype(v.dtype)
    o_meta = jnp.einsum('bkgqs,bskd->bqkgd', p, v[:, :n_front])

    qr = q[:, N_META:].reshape(B, nb, BLOCK, N_KV_B, g, HEAD_DIM)
    kb = _band(k, B, nb)
    vb = _band(v, B, nb)
    s_m = jnp.einsum('bnqkgd,bskd->bkgnqs', qr, k_meta).astype(jnp.float32) * scale
    s_b = jnp.einsum('bnqkgd,bnskd->bkgnqs', qr, kb).astype(jnp.float32) * scale
    i = jnp.arange(BLOCK)[:, None]
    j = jnp.arange(3 * BLOCK)[None, :]
    blk = jnp.arange(nb)[:, None, None]
    rel = i + BLOCK - j
    in_win = jnp.abs(rel) <= WINDOW
    in_rng = ((j >= BLOCK) | (blk > 0)) & ((j < 2 * BLOCK) | (blk < nb - 1))
    s_b = jnp.where(in_win[None] & in_rng, s_b, NEG)
    p = _sink_softmax(jnp.concatenate([s_m, s_b], -1), sink_f[None, :, :, None, None, None]).astype(v.dtype)
    o_real = (jnp.einsum('bkgnqs,bskd->bnqkgd', p[..., :N_META], v_meta)
              + jnp.einsum('bkgnqs,bnskd->bnqkgd', p[..., N_META:], vb))
    o_real = o_real.reshape(B, S, N_KV_B, g, HEAD_DIM)
    return jnp.concatenate([o_meta, o_real], 1).reshape(B, L, N_HEADS_B * HEAD_DIM)


def _mixer_pool(u, w, scale):
    B, L, C = u.shape
    cs = jnp.pad(jnp.cumsum(u.astype(jnp.float32), axis=1), ((0, 0), (1, 0), (0, 0)))
    t = jnp.arange(L)
    outs = []
    for gi, win in enumerate(POOL_WINDOWS):
        lo = jnp.clip(t - win // 2, 0, L)
        hi = jnp.clip(t - win // 2 + win, 0, L)
        sl = slice(gi * POOL_GROUP_DIM, (gi + 1) * POOL_GROUP_DIM)
        c = cs[:, :, sl]
        mean = (c[:, hi] - c[:, lo]) / (hi - lo).astype(jnp.float32)[None, :, None]
        outs.append(mean - u[:, :, sl].astype(jnp.float32))
    d = jnp.stack(outs, 2).astype(u.dtype)
    y = jnp.einsum('blgc,gcd->blgd', d, w).reshape(B, L, C)
    return y * scale


def _split_in(u):
    parts = []
    start = 0
    for wdt in IN_WIDTHS:
        parts.append(u[..., start:start + wdt])
        start += wdt
    return parts


def _trunk(x, meta_tokens, w_in, q_norm_g, k_norm_g, sink_logit, pool_w, pool_scale,
           w_branch_a, w_branch_b, w_out, ln1_g, ln1_b, w_up, w_down, ln2_g, ln2_b):
    B = x.shape[0]
    D = D_MODEL
    meta = jnp.broadcast_to(meta_tokens.astype(x.dtype)[None], (B, N_META, D))
    h = jnp.concatenate([meta, x], axis=1)
    L = h.shape[1]
    for l in range(DEPTH):
        u = h @ w_in[l]
        qa, ka, va, qb, kb, vb, uc, ug = _split_in(u)
        oa = _mixer_global(qa.reshape(B, L, N_HEADS_A, HEAD_DIM), ka.reshape(B, L, N_KV_A, HEAD_DIM),
                           va.reshape(B, L, N_KV_A, HEAD_DIM), q_norm_g[l], k_norm_g[l])
        ob = _mixer_window(qb.reshape(B, L, N_HEADS_B, HEAD_DIM), kb.reshape(B, L, N_KV_B, HEAD_DIM),
                           vb.reshape(B, L, N_KV_B, HEAD_DIM), sink_logit[l])
        ya = oa @ w_branch_a[l]
        yb = ob @ w_branch_b[l]
        yc = _mixer_pool(uc, pool_w[l], pool_scale[l])
        gates = jax.nn.sigmoid(ug.astype(jnp.float32)).reshape(B, L, N_BRANCHES, D)
        merged = (gates[:, :, 0] * ya + gates[:, :, 1] * yb + gates[:, :, 2] * yc).astype(h.dtype)
        h = _layer_norm(ALPHA * h + merged @ w_out[l], ln1_g[l], ln1_b[l])
        gu = h @ w_up[l]
        f = (jax.nn.silu(gu[..., :D_FF]) * gu[..., D_FF:]) @ w_down[l]
        h = _layer_norm(ALPHA * h + f, ln2_g[l], ln2_b[l])
    return h[:, N_META:]


def setup_inputs(seed: int = 0) -> dict:
    key = jax.random.key(seed)
    ks = jax.random.split(key, 18)
    D = D_MODEL

    def nrm(k, shape, s):
        return jax.random.normal(k, shape, jnp.float32) * s

    return {
        "x_prompt": nrm(ks[0], (BATCH, SEQ, D), 1.0),
        "x_sample": nrm(ks[1], (DEC_BATCH, DEC_SEQ, D), 1.0),
        "meta_tokens": nrm(ks[2], (N_META, D), 1.0),
        "w_in": nrm(ks[3], (DEPTH, D, IN_WIDTH), D ** -0.5),
        "q_norm_g": 1.0 + nrm(ks[4], (DEPTH, HEAD_DIM), 0.1),
        "k_norm_g": 1.0 + nrm(ks[5], (DEPTH, HEAD_DIM), 0.1),
        "sink_logit": nrm(ks[6], (DEPTH, N_HEADS_B), 0.5),
        "pool_w": nrm(ks[7], (DEPTH, N_POOL_GROUPS, POOL_GROUP_DIM, POOL_GROUP_DIM), POOL_GROUP_DIM ** -0.5),
        "pool_scale": 1.0 + nrm(ks[8], (DEPTH, D), 0.1),
        "w_branch_a": nrm(ks[9], (DEPTH, N_HEADS_A * HEAD_DIM, D), (N_HEADS_A * HEAD_DIM) ** -0.5),
        "w_branch_b": nrm(ks[10], (DEPTH, N_HEADS_B * HEAD_DIM, D), (N_HEADS_B * HEAD_DIM) ** -0.5),
        "w_out": nrm(ks[11], (DEPTH, D, D), D ** -0.5 * BETA),
        "ln1_g": 1.0 + nrm(ks[12], (DEPTH, D), 0.1),
        "ln1_b": nrm(ks[13], (DEPTH, D), 0.02),
        "w_up": nrm(ks[14], (DEPTH, D, 2 * D_FF), D ** -0.5),
        "w_down": nrm(ks[15], (DEPTH, D_FF, D), D_FF ** -0.5 * BETA),
        "ln2_g": 1.0 + nrm(ks[16], (DEPTH, D), 0.1),
        "ln2_b": nrm(ks[17], (DEPTH, D), 0.02),
    }


def reference(x_prompt, x_sample, meta_tokens, w_in, q_norm_g, k_norm_g, sink_logit, pool_w, pool_scale,
              w_branch_a, w_branch_b, w_out, ln1_g, ln1_b, w_up, w_down, ln2_g, ln2_b):
    y_prompt = _trunk(x_prompt, meta_tokens, w_in, q_norm_g, k_norm_g, sink_logit, pool_w, pool_scale,
                      w_branch_a, w_branch_b, w_out, ln1_g, ln1_b, w_up, w_down, ln2_g, ln2_b)
    y_sample = _trunk(x_sample, meta_tokens, w_in, q_norm_g, k_norm_g, sink_logit, pool_w, pool_scale,
                      w_branch_a, w_branch_b, w_out, ln1_g, ln1_b, w_up, w_down, ln2_g, ln2_b)
    return (y_prompt, y_sample)
```

```cpp
#include <hip/hip_runtime.h>
#include <hip/hip_cooperative_groups.h>
#include <cstdio>
namespace cg = cooperative_groups;

#define LAS __attribute__((address_space(3)))
typedef _Float16 f16;
typedef _Float16 f16x8 __attribute__((ext_vector_type(8)));
typedef _Float16 f16x4 __attribute__((ext_vector_type(4)));
typedef _Float16 f16x2 __attribute__((ext_vector_type(2)));
typedef float f32x4 __attribute__((ext_vector_type(4)));
typedef float f32x16 __attribute__((ext_vector_type(16)));
typedef unsigned u32x4 __attribute__((ext_vector_type(4)));
typedef unsigned u32x2 __attribute__((ext_vector_type(2)));

__device__ __forceinline__ int opaque_tid() { int t = threadIdx.x; asm volatile("" : "+v"(t)); return t; }

constexpr int DM = 1024, INW = 7168, DFF = 2816, NUP = 5632;
constexpr int MROWS = 16896;
constexpr int C_QA = 0, C_KA = 1024, C_VA = 1280, C_QB = 1536, C_KB = 2560, C_VB = 2816, C_UC = 3072, C_UG = 4096;
constexpr float ALPHA = 1.4142135623730951f;
constexpr int NTHR = 512;

constexpr size_t WS_CTL = 0;
constexpr size_t WS_WIN = 4096;
constexpr size_t WS_WA  = WS_WIN + (size_t)2 * INW * DM * 2;
constexpr size_t WS_WB  = WS_WA + (size_t)2 * DM * DM * 2;
constexpr size_t WS_WO  = WS_WB + (size_t)2 * DM * DM * 2;
constexpr size_t WS_WP  = WS_WO + (size_t)2 * DM * DM * 2;
constexpr size_t WS_WUP = WS_WP + (size_t)2 * 4 * 256 * 256 * 2;
constexpr size_t WS_WDN = WS_WUP + (size_t)2 * NUP * DM * 2;
constexpr size_t WS_U   = WS_WDN + (size_t)2 * DM * DFF * 2;
constexpr size_t WS_PD  = WS_U + (size_t)(MROWS + 256) * INW * 2;
constexpr size_t WS_MG  = WS_PD + (size_t)MROWS * DM * 2;
constexpr size_t WS_H16 = WS_MG + (size_t)MROWS * DM * 2;
constexpr size_t WS_H32 = WS_H16 + (size_t)MROWS * DM * 2;
constexpr size_t WS_END = WS_H32 + (size_t)MROWS * DM * 4;
constexpr int LDS_BYTES = 131072 + 256;

struct Args {
  const float* x_prompt; const float* x_sample; const float* meta; const float* w_in; const float* qg; const float* kg; const float* sink;
  const float* pool_w; const float* pool_scale; const float* w_a; const float* w_b; const float* w_out; const float* ln1g; const float* ln1b;
  const float* w_up; const float* w_down; const float* ln2g; const float* ln2b;
  float* out; unsigned char* ws;
};

struct Round { int nseq, S, SB, Mpad, is_sample, b0; };
__device__ __forceinline__ Round get_round(int r) {
  Round R;
  if (r < 2) { R.nseq = 4; R.S = 4096; R.SB = 4224; R.Mpad = 16896; R.is_sample = 0; R.b0 = r * 4; }
  else       { R.nseq = 1; R.S = 16384; R.SB = 16512; R.Mpad = 16640; R.is_sample = 1; R.b0 = r - 2; }
  return R;
}

__device__ __forceinline__ void tp_tile(const float* __restrict__ src, int lds_, int k0, int n0, f16* __restrict__ dst, int ldd, int drow0,
                                        const float* __restrict__ scale, float* tile) {
  const int t = opaque_tid();
#pragma unroll
  for (int p = 0; p < 2; ++p) {
    const int r = (t >> 4) + 32 * p, c4 = (t & 15) * 4;
    const f32x4 v = *(const f32x4*)(src + (size_t)(k0 + r) * lds_ + n0 + c4);
    tile[r * 65 + c4 + 0] = v[0]; tile[r * 65 + c4 + 1] = v[1]; tile[r * 65 + c4 + 2] = v[2]; tile[r * 65 + c4 + 3] = v[3];
  }
  __syncthreads();
  {
    const int n = t >> 3, k8 = (t & 7) * 8;
    const float sc = scale ? scale[n0 + n] : 1.0f;
    f16x8 o;
#pragma unroll
    for (int i = 0; i < 8; ++i) o[i] = (f16)(tile[(k8 + i) * 65 + n] * sc);
    *(f16x8*)(dst + (size_t)(drow0 + n) * ldd + k0 + k8) = o;
  }
  __syncthreads();
}

__device__ __forceinline__ void phase_weights(const Args& a, float* tile) {
  constexpr int T_IN = 16 * 112, T_SQ = 16 * 16, T_UP = 16 * 88, T_DN = 44 * 16, T_PL = 4 * 16;
  constexpr int T_LAYER = T_IN + 3 * T_SQ + T_UP + T_DN + T_PL;
  unsigned char* ws = a.ws;
  for (int idx = blockIdx.x; idx < 2 * T_LAYER; idx += gridDim.x) {
    const int l = idx / T_LAYER; int j = idx % T_LAYER;
    if (j < T_IN) { const int kt = j / 112, nt = j % 112;
      tp_tile(a.w_in + (size_t)l * DM * INW, INW, kt * 64, nt * 64, (f16*)(ws + WS_WIN) + (size_t)l * INW * DM, DM, nt * 64, nullptr, tile); continue; }
    j -= T_IN;
    if (j < 3 * T_SQ) { const int w = j / T_SQ, jj = j % T_SQ, kt = jj / 16, nt = jj % 16;
      const float* src = (w == 0 ? a.w_a : (w == 1 ? a.w_b : a.w_out)) + (size_t)l * DM * DM;
      f16* dst = (f16*)(ws + (w == 0 ? WS_WA : (w == 1 ? WS_WB : WS_WO))) + (size_t)l * DM * DM;
      tp_tile(src, DM, kt * 64, nt * 64, dst, DM, nt * 64, nullptr, tile); continue; }
    j -= 3 * T_SQ;
    if (j < T_UP) { const int kt = j / 88, nt = j % 88; const int n0 = nt * 64, bj = n0 / DFF, rem = n0 % DFF, p = rem / 128, j0 = rem % 128;
      tp_tile(a.w_up + (size_t)l * DM * NUP, NUP, kt * 64, n0, (f16*)(ws + WS_WUP) + (size_t)l * NUP * DM, DM, p * 256 + bj * 128 + j0, nullptr, tile); continue; }
    j -= T_UP;
    if (j < T_DN) { const int kt = j / 16, nt = j % 16;
      tp_tile(a.w_down + (size_t)l * DFF * DM, DM, kt * 64, nt * 64, (f16*)(ws + WS_WDN) + (size_t)l * DM * DFF, DFF, nt * 64, nullptr, tile); continue; }
    j -= T_DN;
    { const int g = j / 16, jj = j % 16, kt = jj / 4, nt = jj % 4;
      tp_tile(a.pool_w + ((size_t)l * 4 + g) * 256 * 256, 256, kt * 64, nt * 64, (f16*)(ws + WS_WP) + ((size_t)l * 4 + g) * 256 * 256, 256, nt * 64,
              a.pool_scale + (size_t)l * DM + g * 256, tile); }
  }
}

__device__ __forceinline__ int row_kind(const Round& R, int row, int& s, int& o) {
  if (row >= R.nseq * R.SB) return 0;
  s = row / R.SB; const int q = row - s * R.SB;
  if (q < 16) { o = q; return 1; }
  if (q < 64) return 0;
  if (q < 64 + R.S) { o = q - 64; return 2; }
  return 0;
}
__device__ __forceinline__ const float* x_row(const Args& a, const Round& R, int s, int i) {
  return R.is_sample ? a.x_sample + ((size_t)R.b0 * 16384 + i) * DM : a.x_prompt + ((size_t)(R.b0 + s) * 4096 + i) * DM;
}
__device__ __forceinline__ float* out_row(const Args& a, const Round& R, int s, int i) {
  return R.is_sample ? a.out + (size_t)8 * 4096 * DM + ((size_t)R.b0 * 16384 + i) * DM : a.out + ((size_t)(R.b0 + s) * 4096 + i) * DM;
}
__device__ __forceinline__ void store_h(const Args& a, int row, int lane, const f32x4 (&v)[4]) {
  float* h32 = (float*)(a.ws + WS_H32) + (size_t)row * DM; f16* h16 = (f16*)(a.ws + WS_H16) + (size_t)row * DM;
#pragma unroll
  for (int i = 0; i < 4; ++i) { const int c = i * 256 + lane * 4;
    *(f32x4*)(h32 + c) = v[i];
    f16x4 h = {(f16)v[i][0], (f16)v[i][1], (f16)v[i][2], (f16)v[i][3]}; *(f16x4*)(h16 + c) = h; }
}
__device__ __forceinline__ void init_row(const Args& a, const Round& R, int row, int lane) {
  int s = 0, o = 0; const int kd = row_kind(R, row, s, o);
  f32x4 v[4];
  const float* src = kd == 1 ? a.meta + (size_t)o * DM : (kd == 2 ? x_row(a, R, s, o) : nullptr);
#pragma unroll
  for (int i = 0; i < 4; ++i) v[i] = src ? *(const f32x4*)(src + i * 256 + lane * 4) : (f32x4){0.f, 0.f, 0.f, 0.f};
  store_h(a, row, lane, v);
}
__device__ __forceinline__ void ln_row(const Args& a, const Round& R, int row, int lane, const float* __restrict__ g, const float* __restrict__ b, int to_out) {
  const float* h32 = (const float*)(a.ws + WS_H32) + (size_t)row * DM;
  f32x4 v[4]; float s = 0.f;
#pragma unroll
  for (int i = 0; i < 4; ++i) { v[i] = *(const f32x4*)(h32 + i * 256 + lane * 4); s += (v[i][0] + v[i][1]) + (v[i][2] + v[i][3]); }
#pragma unroll
  for (int o = 32; o >= 1; o >>= 1) s += __shfl_xor(s, o);
  const float mu = s * (1.0f / DM); float q = 0.f;
#pragma unroll
  for (int i = 0; i < 4; ++i) { const f32x4 d = v[i] - mu; q += (d[0] * d[0] + d[1] * d[1]) + (d[2] * d[2] + d[3] * d[3]); }
#pragma unroll
  for (int o = 32; o >= 1; o >>= 1) q += __shfl_xor(q, o);
  const float rstd = 1.0f / sqrtf(q * (1.0f / DM) + 1e-5f);
#pragma unroll
  for (int i = 0; i < 4; ++i) { const f32x4 gg = *(const f32x4*)(g + i * 256 + lane * 4), bb = *(const f32x4*)(b + i * 256 + lane * 4); v[i] = (v[i] - mu) * rstd * gg + bb; }
  if (!to_out) { store_h(a, row, lane, v); return; }
  int sq = 0, o = 0; const int kd = row_kind(R, row, sq, o);
  if (kd == 2) { float* dst = out_row(a, R, sq, o);
#pragma unroll
    for (int i = 0; i < 4; ++i) *(f32x4*)(dst + i * 256 + lane * 4) = v[i]; }
}
__device__ __forceinline__ void phase_rows(const Args& a, const Round& R, int mode, const float* g, const float* b, int rn) {
  const int tid_ = opaque_tid(); const int wid = tid_ >> 6, lane = tid_ & 63;
  const int nw = gridDim.x * 8;
  if (mode != 0) for (int row = blockIdx.x * 8 + wid; row < R.Mpad; row += nw) ln_row(a, R, row, lane, g, b, mode == 2);
  if (mode == 1 || rn < 0) return;
  const Round Rn = get_round(rn);
  for (int row = blockIdx.x * 8 + wid; row < MROWS; row += nw) { if (row < Rn.Mpad) init_row(a, Rn, row, lane); }
}

constexpr int BM = 256, BK = 64, HALF = 128, HTB = HALF * BK * 2, NXCD = 8, WGM = 8;
__device__ __forceinline__ int lds_byte(int r, int c) { const int st = (r >> 4) * 2 + (c >> 5), rr = r & 15, cc = c & 31, ob = rr * 64 + cc * 2; return st * 1024 + (ob ^ (((ob >> 9) & 1) << 5)); }
__device__ __forceinline__ void stage_rc(int b, int& R, int& C) { const int st = b / 1024, sb = b % 1024, swz = sb ^ (((sb >> 9) & 1) << 5); R = (st >> 1) * 16 + swz / 64; C = (st & 1) * 32 + (swz % 64) / 2; }

struct GUnit { const char* A; const char* B; int pm, pn; };

__device__ __forceinline__ void tile_map(int L, int nM, int nN, int& pm, int& pn) {
  const int nwg = nM * nN; int wgid = L;
  { const int q = nwg / NXCD, r = nwg % NXCD, xcd = wgid % NXCD, off = wgid / NXCD; wgid = (xcd < r ? xcd * (q + 1) : r * (q + 1) + (xcd - r) * q) + off; }
  const int nig = WGM * nN, gid = wgid / nig, fm = gid * WGM, gsz = (nM - fm) < WGM ? (nM - fm) : WGM;
  pm = fm + ((wgid % nig) % gsz); pn = (wgid % nig) / gsz;
}

template <int LDA2, int LDB2, int NT, class Sched, class Epi>
__device__ __forceinline__ void gemm_phase(LAS unsigned char* lds, const Sched& S, const Epi& E) {
  const int tid = opaque_tid(), wid = __builtin_amdgcn_readfirstlane(tid >> 6), lane = tid & 63, wr = wid >> 2, wc = wid & 3, fr = lane & 15, fq = lane >> 4;
  unsigned voffA[2], voffB[2];
#pragma unroll
  for (int i = 0; i < 2; ++i) { int R, C; stage_rc(tid * 16 + i * 8192, R, C); voffA[i] = (unsigned)(R * LDA2 + C * 2); voffB[i] = (unsigned)(R * LDB2 + C * 2); }
  constexpr size_t kstep = (size_t)(BK * 2);
  constexpr size_t hA = (size_t)HALF * LDA2, hB = (size_t)HALF * LDB2;
  const unsigned ldsw = (unsigned)wid * 1024u;
  const int aoff = lds_byte(wr * 64 + fr, fq * 8), boff = lds_byte(wc * 32 + fr, fq * 8);
#define G_SA(b, h) (((b) * 2 + (h)) * HTB)
#define G_SB(b, h) ((4 + (b) * 2 + (h)) * HTB)
#define G_STAGE(bufoff, gbase, voff) do { _Pragma("unroll") for (int _i = 0; _i < 2; ++_i) \
    __builtin_amdgcn_global_load_lds((const unsigned*)((const char*)(gbase) + (voff)[_i]), (LAS unsigned*)(lds + (bufoff) + ldsw + _i * 8192), 16, 0, 0); } while (0)
#define G_LDA(dst, b, h) do { _Pragma("unroll") for (int m = 0; m < 4; ++m) _Pragma("unroll") for (int k = 0; k < 2; ++k) dst[m][k] = *(const LAS f16x8*)(lds + G_SA(b, h) + aoff + m * 2048 + k * 1024); } while (0)
#define G_LDB(dst, b, h) do { _Pragma("unroll") for (int n = 0; n < 2; ++n) _Pragma("unroll") for (int k = 0; k < 2; ++k) dst[n][k] = *(const LAS f16x8*)(lds + G_SB(b, h) + boff + n * 2048 + k * 1024); } while (0)
#define G_MMA(ai, bj, At, Bt) do { __builtin_amdgcn_s_setprio(1); _Pragma("unroll") for (int m = 0; m < 4; ++m) _Pragma("unroll") for (int n = 0; n < 2; ++n) _Pragma("unroll") for (int k = 0; k < 2; ++k) \
    acc[ai][bj][m][n] = __builtin_amdgcn_mfma_f32_16x16x32_f16(Bt[n][k], At[m][k], acc[ai][bj][m][n], 0, 0, 0); __builtin_amdgcn_s_setprio(0); } while (0)
#define G_WAIT_V(n) asm volatile("s_waitcnt vmcnt(" #n ")" ::: "memory")
#define G_WAIT_L(n) asm volatile("s_waitcnt lgkmcnt(" #n ")" ::: "memory")
#define G_BAR __builtin_amdgcn_s_barrier()
#define G_SCHED __builtin_amdgcn_sched_barrier(0)
  GUnit cur, nxt; int ui = 0;
  if (!S.next(0, cur)) return;
  f32x4 acc[2][2][4][2];
#pragma unroll
  for (int a = 0; a < 2; ++a)
#pragma unroll
    for (int b = 0; b < 2; ++b)
#pragma unroll
      for (int m = 0; m < 4; ++m)
#pragma unroll
        for (int n = 0; n < 2; ++n) acc[a][b][m][n] = (f32x4){0.f, 0.f, 0.f, 0.f};
  f16x8 At[4][2], B0[2][2], B1[2][2];
  const char* cA = cur.A; const char* cB = cur.B;
  G_STAGE(G_SB(0, 0), cB, voffB); G_STAGE(G_SA(0, 0), cA, voffA); G_STAGE(G_SB(0, 1), cB + hB, voffB); G_STAGE(G_SA(0, 1), cA + hA, voffA);
  if (wr == 1) G_BAR;
  G_WAIT_V(4); G_BAR;
  G_STAGE(G_SB(1, 0), cB + kstep, voffB); G_STAGE(G_SA(1, 0), cA + kstep, voffA); G_STAGE(G_SB(1, 1), cB + hB + kstep, voffB);
  G_WAIT_V(6); G_BAR;
  for (;;) {
    const bool has_next = S.next(ui + 1, nxt);
    const char* nA = has_next ? nxt.A : cA; const char* nB = has_next ? nxt.B : cB;
#pragma unroll 1
    for (int t = 0; t < NT; t += 2) {
      const bool last = (t == NT - 2);
      const char* a1 = cA + (size_t)(t + 1) * kstep;
      const char* a2 = last ? nA : cA + (size_t)(t + 2) * kstep; const char* b2 = last ? nB : cB + (size_t)(t + 2) * kstep;
      const char* a3 = a2 + kstep; const char* b3 = b2 + kstep;
      G_LDB(B0, 0, 0); G_SCHED; G_LDA(At, 0, 0); G_STAGE(G_SA(1, 1), a1 + hA, voffA);
      G_WAIT_L(8); G_BAR; G_WAIT_L(0); G_MMA(0, 0, At, B0); G_BAR; G_SCHED;
      G_LDB(B1, 0, 1); G_STAGE(G_SB(0, 0), b2, voffB);
      G_BAR; G_WAIT_L(0); G_MMA(0, 1, At, B1); G_BAR;
      G_LDA(At, 0, 1); G_STAGE(G_SA(0, 0), a2, voffA);
      G_BAR; G_WAIT_L(0); G_MMA(1, 0, At, B0); G_BAR; G_SCHED;
      G_STAGE(G_SB(0, 1), b2 + hB, voffB);
      G_WAIT_V(6); G_BAR; G_MMA(1, 1, At, B1); G_BAR;
      G_LDB(B0, 1, 0); G_SCHED; G_LDA(At, 1, 0); G_STAGE(G_SA(0, 1), a2 + hA, voffA);
      G_WAIT_L(8); G_BAR; G_WAIT_L(0); G_MMA(0, 0, At, B0); G_BAR; G_SCHED;
      G_LDB(B1, 1, 1); G_STAGE(G_SB(1, 0), b3, voffB);
      G_BAR; G_WAIT_L(0); G_MMA(0, 1, At, B1); G_BAR;
      G_LDA(At, 1, 1); G_STAGE(G_SA(1, 0), a3, voffA);
      G_BAR; G_WAIT_L(0); G_MMA(1, 0, At, B0); G_BAR; G_SCHED;
      G_STAGE(G_SB(1, 1), b3 + hB, voffB);
      G_WAIT_V(6); G_BAR; G_MMA(1, 1, At, B1); G_BAR;
    }
    E(acc, cur, wr, wc, fr, fq);
    if (!has_next) break;
#pragma unroll
    for (int a = 0; a < 2; ++a)
#pragma unroll
      for (int b = 0; b < 2; ++b)
#pragma unroll
        for (int m = 0; m < 4; ++m)
#pragma unroll
          for (int n = 0; n < 2; ++n) acc[a][b][m][n] = (f32x4){0.f, 0.f, 0.f, 0.f};
    cur = nxt; cA = nA; cB = nB; ++ui;
  }
  G_WAIT_V(0);
  if (wr == 0) G_BAR;
  G_BAR;
#undef G_SA
#undef G_SB
#undef G_STAGE
#undef G_LDA
#undef G_LDB
#undef G_MMA
#undef G_WAIT_V
#undef G_WAIT_L
#undef G_BAR
#undef G_SCHED
}

template <int PH> struct Sched {
  const unsigned char* ws; int l, nM, G, c;
  __device__ __forceinline__ bool next(int i, GUnit& u) const {
    constexpr int nN = PH == 1 ? 28 : (PH == 7 ? 22 : 4);
    const long L = (long)i * G + c; if (L >= (long)nM * nN) return false;
    int pm, pn; tile_map((int)L, nM, nN, pm, pn);
    u.pm = pm; u.pn = pn;
    if (PH == 1)  { u.A = (const char*)(ws + WS_H16) + (size_t)pm * 256 * DM * 2; u.B = (const char*)(ws + WS_WIN) + ((size_t)l * INW + (size_t)pn * 256) * DM * 2; }
    if (PH == 40) { u.A = (const char*)(ws + WS_U) + ((size_t)pm * 256 * INW + C_QA) * 2; u.B = (const char*)(ws + WS_WA) + ((size_t)l * DM + (size_t)pn * 256) * DM * 2; }
    if (PH == 41) { u.A = (const char*)(ws + WS_U) + ((size_t)pm * 256 * INW + C_QB) * 2; u.B = (const char*)(ws + WS_WB) + ((size_t)l * DM + (size_t)pn * 256) * DM * 2; }
    if (PH == 42) { u.A = (const char*)(ws + WS_PD) + ((size_t)pm * 256 * DM + pn * 256) * 2; u.B = (const char*)(ws + WS_WP) + ((size_t)l * 4 + pn) * 256 * 256 * 2; }
    if (PH == 5)  { u.A = (const char*)(ws + WS_MG) + (size_t)pm * 256 * DM * 2; u.B = (const char*)(ws + WS_WO) + ((size_t)l * DM + (size_t)pn * 256) * DM * 2; }
    if (PH == 7)  { u.A = (const char*)(ws + WS_H16) + (size_t)pm * 256 * DM * 2; u.B = (const char*)(ws + WS_WUP) + ((size_t)l * NUP + (size_t)pn * 256) * DM * 2; }
    if (PH == 8)  { u.A = (const char*)(ws + WS_U) + (size_t)pm * 256 * DFF * 2; u.B = (const char*)(ws + WS_WDN) + ((size_t)l * DM + (size_t)pn * 256) * DFF * 2; }
    return true;
  }
};

__device__ __forceinline__ f16x4 to_h4(f32x4 v) { f16x4 h = {(f16)v[0], (f16)v[1], (f16)v[2], (f16)v[3]}; return h; }
__device__ __forceinline__ f32x4 to_f4(f16x4 h) { f32x4 v = {(float)h[0], (float)h[1], (float)h[2], (float)h[3]}; return v; }
struct EpiU {
  unsigned char* ws;
  __device__ __forceinline__ void operator()(const f32x4 (&acc)[2][2][4][2], const GUnit& u, int wr, int wc, int fr, int fq) const {
    f16* U = (f16*)(ws + WS_U);
    const int row0 = u.pm * BM + wr * 64 + fr, col0 = u.pn * BM + wc * 32 + 4 * fq;
#pragma unroll
    for (int ai = 0; ai < 2; ++ai)
#pragma unroll
      for (int m = 0; m < 4; ++m) { f16* rowp = U + (size_t)(row0 + ai * HALF + m * 16) * INW + col0;
#pragma unroll
        for (int bj = 0; bj < 2; ++bj)
#pragma unroll
          for (int n = 0; n < 2; ++n) *(f16x4*)(rowp + bj * HALF + n * 16) = to_h4(acc[ai][bj][m][n]); }
  }
};
template <int KIND> struct EpiGate {
  unsigned char* ws;
  __device__ __forceinline__ void operator()(const f32x4 (&acc)[2][2][4][2], const GUnit& u, int wr, int wc, int fr, int fq) const {
    const f16* U = (const f16*)(ws + WS_U); f16* MG = (f16*)(ws + WS_MG);
    const int row0 = u.pm * BM + wr * 64 + fr, col0 = u.pn * BM + wc * 32 + 4 * fq;
    constexpr int kind = KIND;
#pragma unroll
    for (int ai = 0; ai < 2; ++ai)
#pragma unroll
      for (int m = 0; m < 4; ++m) { const size_t row = (size_t)(row0 + ai * HALF + m * 16);
        const f16* gp = U + row * INW + C_UG + kind * DM + col0; f16* mp = MG + row * DM + col0;
#pragma unroll
        for (int bj = 0; bj < 2; ++bj)
#pragma unroll
          for (int n = 0; n < 2; ++n) { const f32x4 g = to_f4(*(const f16x4*)(gp + bj * HALF + n * 16)); f32x4 v = acc[ai][bj][m][n];
#pragma unroll
            for (int j = 0; j < 4; ++j) v[j] = v[j] / (1.0f + __expf(-g[j]));
            if (kind != 0) v += to_f4(*(const f16x4*)(mp + bj * HALF + n * 16));
            *(f16x4*)(mp + bj * HALF + n * 16) = to_h4(v); } }
  }
};
struct EpiResid {
  unsigned char* ws;
  __device__ __forceinline__ void operator()(const f32x4 (&acc)[2][2][4][2], const GUnit& u, int wr, int wc, int fr, int fq) const {
    float* H = (float*)(ws + WS_H32);
    const int row0 = u.pm * BM + wr * 64 + fr, col0 = u.pn * BM + wc * 32 + 4 * fq;
#pragma unroll
    for (int ai = 0; ai < 2; ++ai)
#pragma unroll
      for (int m = 0; m < 4; ++m) { float* rowp = H + (size_t)(row0 + ai * HALF + m * 16) * DM + col0;
#pragma unroll
        for (int bj = 0; bj < 2; ++bj)
#pragma unroll
          for (int n = 0; n < 2; ++n) { const f32x4 o = *(const f32x4*)(rowp + bj * HALF + n * 16); *(f32x4*)(rowp + bj * HALF + n * 16) = o * ALPHA + acc[ai][bj][m][n]; } }
  }
};
struct EpiSwiglu {
  unsigned char* ws;
  __device__ __forceinline__ void operator()(const f32x4 (&acc)[2][2][4][2], const GUnit& u, int wr, int wc, int fr, int fq) const {
    f16* HID = (f16*)(ws + WS_U);
    const int row0 = u.pm * BM + wr * 64 + fr, col0 = u.pn * HALF + wc * 32 + 4 * fq;
#pragma unroll
    for (int ai = 0; ai < 2; ++ai)
#pragma unroll
      for (int m = 0; m < 4; ++m) { f16* rowp = HID + (size_t)(row0 + ai * HALF + m * 16) * DFF + col0;
#pragma unroll
        for (int n = 0; n < 2; ++n) { const f32x4 g = acc[ai][0][m][n], up = acc[ai][1][m][n]; f32x4 v;
#pragma unroll
          for (int j = 0; j < 4; ++j) v[j] = g[j] / (1.0f + __expf(-g[j])) * up[j];
          *(f16x4*)(rowp + n * 16) = to_h4(v); } }
  }
};

__device__ __forceinline__ float wave_sum(float s) {
#pragma unroll
  for (int o = 32; o >= 1; o >>= 1) s += __shfl_xor(s, o);
  return s;
}
__device__ __forceinline__ void sincos_turns(float ang, float& sn, float& cs) {
  const double t = (double)ang * 0.15915494309189533577;
  const float fr = (float)(t - floor(t));
  sn = __builtin_amdgcn_sinf(fr); cs = __builtin_amdgcn_cosf(fr);
}
__device__ __forceinline__ void phase_prep(const Args& a, const Round& R, int l) {
  const int tid_ = opaque_tid(); const int wid = tid_ >> 6, lane = tid_ & 63;
  f16* U = (f16*)(a.ws + WS_U); f16* PD = (f16*)(a.ws + WS_PD);
  const int L = R.S + 16, ntok = R.nseq * L;
  const int iA = lane & 31, secA = lane >> 5;
  const int dA1 = secA * 64 + iA, dA2 = dA1 + 32;
  const int dB1 = lane, dB2 = lane + 64;
  const float invA = (float)exp2(-(double)(2 * iA) / 64.0 * 13.287712379549449);
  const float invB = (float)exp2(-(double)(2 * lane) / 128.0 * 13.287712379549449);
  const float gq1 = a.qg[l * 128 + dA1], gq2 = a.qg[l * 128 + dA2], gk1 = a.kg[l * 128 + dA1], gk2 = a.kg[l * 128 + dA2];
  const int pg = lane >> 4, win = 2 << pg, c0 = lane * 16;
  for (int tok = blockIdx.x * 8 + wid; tok < ntok; tok += gridDim.x * 8) {
    const int s = tok / L, t = tok - s * L;
    const int base = s * R.SB;
    const int row = base + (t < 16 ? t : t + 48);
    f16* up = U + (size_t)row * INW;
    int prow, pcol;
    if (t < 16) { prow = -1; pcol = t; } else { const int i = t - 16; prow = i >> 6; pcol = i & 63; }
    float snA, csA, snB, csB;
    sincos_turns((float)(secA ? pcol : prow) * invA, snA, csA);
    sincos_turns((float)t * invB, snB, csB);
#pragma unroll
    for (int h = 0; h < 10; ++h) {
      f16* p = up + (h < 8 ? C_QA + h * 128 : C_KA + (h - 8) * 128);
      float x1 = (float)p[dA1], x2 = (float)p[dA2];
      const float ss = wave_sum(x1 * x1 + x2 * x2);
      const float rs = 1.0f / sqrtf(ss * (1.0f / 128.0f) + 1e-6f);
      x1 = x1 * rs * (h < 8 ? gq1 : gk1); x2 = x2 * rs * (h < 8 ? gq2 : gk2);
      p[dA1] = (f16)(x1 * csA - x2 * snA); p[dA2] = (f16)(x1 * snA + x2 * csA);
    }
#pragma unroll
    for (int h = 0; h < 10; ++h) {
      f16* p = up + (h < 8 ? C_QB + h * 128 : C_KB + (h - 8) * 128);
      const float x1 = (float)p[dB1], x2 = (float)p[dB2];
      p[dB1] = (f16)(x1 * csB - x2 * snB); p[dB2] = (f16)(x1 * snB + x2 * csB);
    }
    {
      int lo = t - win / 2; int hi = lo + win; lo = lo < 0 ? 0 : lo; hi = hi > L ? L : hi;
      float acc[16];
#pragma unroll
      for (int j = 0; j < 16; ++j) acc[j] = 0.f;
      for (int tt = lo; tt < hi; ++tt) {
        const f16* q = U + (size_t)(base + (tt < 16 ? tt : tt + 48)) * INW + C_UC + c0;
        const f16x8 v0 = *(const f16x8*)q, v1 = *(const f16x8*)(q + 8);
#pragma unroll
        for (int j = 0; j < 8; ++j) { acc[j] += (float)v0[j]; acc[8 + j] += (float)v1[j]; }
      }
      const float rc = 1.0f / (float)(hi - lo);
      const f16x8 s0 = *(const f16x8*)(up + C_UC + c0), s1 = *(const f16x8*)(up + C_UC + c0 + 8);
      f16x8 o0, o1;
#pragma unroll
      for (int j = 0; j < 8; ++j) { o0[j] = (f16)(acc[j] * rc - (float)s0[j]); o1[j] = (f16)(acc[8 + j] * rc - (float)s1[j]); }
      *(f16x8*)(PD + (size_t)row * DM + c0) = o0; *(f16x8*)(PD + (size_t)row * DM + c0 + 8) = o1;
    }
  }
}

constexpr int AD = 128, KVBLK = 64, LDQ = INW;
constexpr float ASCALE = 0.088388347648318440f;
constexpr float ATHR = 8.f;
constexpr int SHM_V = KVBLK * AD * 2, SHM_K = KVBLK * AD * 2;
typedef short s16x4 __attribute__((ext_vector_type(4)));
#define KSWZ(row, colB) ((row) * 256 + ((colB) ^ (((row) & 7) << 4)))
#define SBAR() __builtin_amdgcn_sched_barrier(0)
__device__ __forceinline__ int crow(int r, int hi) { return (r & 3) + 8 * (r >> 2) + 4 * hi; }
__device__ __forceinline__ unsigned cvtpk(float lo, float hi) { f16x2 v = {(f16)lo, (f16)hi}; return __builtin_bit_cast(unsigned, v); }

__device__ __forceinline__ void partialSM(f32x16& p0, f32x16& p1, float& m_reg, float& mn, float& alpha) {
  constexpr float C = ASCALE * 1.4426950408889634f;
  float pmax = p0[0];
#pragma unroll
  for (int r = 1; r < 16; ++r) pmax = fmaxf(pmax, p0[r]);
#pragma unroll
  for (int r = 0; r < 16; ++r) pmax = fmaxf(pmax, p1[r]);
  { auto rr = __builtin_amdgcn_permlane32_swap(__float_as_uint(pmax), __float_as_uint(pmax), false, false);
    pmax = fmaxf(__uint_as_float(rr[0]), __uint_as_float(rr[1])); }
  if (__builtin_expect(__all(pmax - m_reg <= ATHR / ASCALE), 1)) { mn = m_reg; alpha = 1.f; }
  else { mn = fmaxf(m_reg, pmax); alpha = __builtin_amdgcn_exp2f((m_reg - mn) * C); m_reg = mn; }
  const float mnC = -mn * C;
#pragma unroll
  for (int r = 0; r < 16; ++r) p0[r] = fmaf(p0[r], C, mnC);
#pragma unroll
  for (int r = 0; r < 16; ++r) p1[r] = fmaf(p1[r], C, mnC);
#pragma unroll
  for (int r = 0; r < 16; ++r) p0[r] = __builtin_amdgcn_exp2f(p0[r]);
}
__device__ __forceinline__ void finishSM(f32x16& p0, f32x16& p1, float alpha, float& l_reg, f16x8& pa0, f16x8& pa1, f16x8& pa2, f16x8& pa3) {
#pragma unroll
  for (int r = 0; r < 16; ++r) p1[r] = __builtin_amdgcn_exp2f(p1[r]);
  float ps = 0;
#pragma unroll
  for (int r = 0; r < 16; ++r) ps += p0[r];
#pragma unroll
  for (int r = 0; r < 16; ++r) ps += p1[r];
  { auto rr = __builtin_amdgcn_permlane32_swap(__float_as_uint(ps), __float_as_uint(ps), false, false);
    ps = __uint_as_float(rr[0]) + __uint_as_float(rr[1]); }
  l_reg = l_reg * alpha + ps;
#define PK4(P, BASE, OUT) do { unsigned a0 = cvtpk(P[BASE + 0], P[BASE + 1]), a1 = cvtpk(P[BASE + 2], P[BASE + 3]);   \
    unsigned b0 = cvtpk(P[BASE + 4], P[BASE + 5]), b1 = cvtpk(P[BASE + 6], P[BASE + 7]);                              \
    auto r0 = __builtin_amdgcn_permlane32_swap(a0, b0, false, false); auto r1 = __builtin_amdgcn_permlane32_swap(a1, b1, false, false); \
    u32x4 w = {r0[0], r1[0], r0[1], r1[1]}; OUT = __builtin_bit_cast(f16x8, w); } while (0)
  PK4(p0, 0, pa0); PK4(p0, 8, pa1); PK4(p1, 0, pa2); PK4(p1, 8, pa3);
#undef PK4
}
__device__ __forceinline__ void qkt(f32x16& p0, f32x16& p1, const char* Ks, const f16x8* qr, int r32, int hi) {
  p0 = f32x16{}; p1 = f32x16{};
#pragma unroll
  for (int d0 = 0; d0 < 8; ++d0) { const int cb = (d0 * 16 + hi * 8) * 2;
    const f16x8 b0 = *reinterpret_cast<const f16x8*>(Ks + KSWZ(r32, cb));
    const f16x8 b1 = *reinterpret_cast<const f16x8*>(Ks + KSWZ(32 + r32, cb));
    p0 = __builtin_amdgcn_mfma_f32_32x32x16_f16(b0, qr[d0], p0, 0, 0, 0);
    p1 = __builtin_amdgcn_mfma_f32_32x32x16_f16(b1, qr[d0], p1, 0, 0, 0); }
}
__device__ __forceinline__ void mask_tile(f32x16& p0, f32x16& p1, int ka, int kb, int hi) {
  const int a2 = ka - 4 * hi; const unsigned span = (unsigned)(kb - ka);
#pragma unroll
  for (int r = 0; r < 16; ++r) { const int c = (r & 3) + 8 * (r >> 2);
    p0[r] = ((unsigned)(c - a2) <= span && kb >= ka) ? p0[r] : -1e30f;
    p1[r] = ((unsigned)(c + 32 - a2) <= span && kb >= ka) ? p1[r] : -1e30f; }
}
__device__ __forceinline__ int v_st(int k, int c) { const int kk = (k & ~0xC) | ((k & 4) << 1) | ((k & 8) >> 1); return ((kk >> 3) * 4 + (c >> 5)) * 512 + ((kk & 7) * 32 + (c & 31)) * 2; }
__device__ __forceinline__ int v_rd_base(int lane) { return ((lane & 3) << 3) | (((lane >> 2) & 3) << 6) | (((lane >> 4) & 1) << 5) | (((lane >> 5) & 1) << 8); }
constexpr int v_rd_off(int d0, int ks, int half) { return d0 * 512 + ks * 4096 + half * 2048; }
template <int OFF> __device__ __forceinline__ s16x4 tr_read(int vb) {
  s16x4 r; asm volatile("ds_read_b64_tr_b16 %0, %1 offset:%2" : "=&v"(r) : "v"(vb), "i"(OFF) : "memory"); return r;
}
template <int D0> __device__ __forceinline__ void pv_one(f32x16& od, int vb, f16x8 pa0, f16x8 pa1, f16x8 pa2, f16x8 pa3) {
  const s16x4 l0 = tr_read<v_rd_off(D0, 0, 0)>(vb), h0 = tr_read<v_rd_off(D0, 0, 1)>(vb), l1 = tr_read<v_rd_off(D0, 1, 0)>(vb), h1 = tr_read<v_rd_off(D0, 1, 1)>(vb);
  const s16x4 l2 = tr_read<v_rd_off(D0, 2, 0)>(vb), h2 = tr_read<v_rd_off(D0, 2, 1)>(vb), l3 = tr_read<v_rd_off(D0, 3, 0)>(vb), h3 = tr_read<v_rd_off(D0, 3, 1)>(vb);
  asm volatile("s_waitcnt lgkmcnt(0)" ::: "memory"); SBAR();
  typedef short s16x8 __attribute__((ext_vector_type(8)));
#define PK(L, H) __builtin_bit_cast(f16x8, (s16x8){L[0], L[1], L[2], L[3], H[0], H[1], H[2], H[3]})
  od = __builtin_amdgcn_mfma_f32_32x32x16_f16(pa0, PK(l0, h0), od, 0, 0, 0);
  od = __builtin_amdgcn_mfma_f32_32x32x16_f16(pa1, PK(l1, h1), od, 0, 0, 0);
  od = __builtin_amdgcn_mfma_f32_32x32x16_f16(pa2, PK(l2, h2), od, 0, 0, 0);
  od = __builtin_amdgcn_mfma_f32_32x32x16_f16(pa3, PK(l3, h3), od, 0, 0, 0);
#undef PK
}
__device__ __forceinline__ void pv_d0(f32x16* o, int vb, f16x8 pa0, f16x8 pa1, f16x8 pa2, f16x8 pa3) {
  pv_one<0>(o[0], vb, pa0, pa1, pa2, pa3); pv_one<1>(o[1], vb, pa0, pa1, pa2, pa3); pv_one<2>(o[2], vb, pa0, pa1, pa2, pa3); pv_one<3>(o[3], vb, pa0, pa1, pa2, pa3);
}

template <int MODE>
__device__ __forceinline__ void attn_body(const f16* Qb, const f16* __restrict__ Kh, const f16* __restrict__ Vh, int NT, int tstart, int Tmax,
                                          int klo, int khi, float sink, int nvalid, char* lds) {
  const int tid = opaque_tid(), wid = tid >> 6, lane = tid & 63, r32 = lane & 31, hi = lane >> 5;
  char* V_lds = lds; char* K_lds = lds + 2 * SHM_V;
  float* wsf = (float*)(lds + 2 * SHM_V + 2 * SHM_K) + wid * 64; float* li_l = wsf; float* al_l = wsf + 32;
  float m_reg = -1e30f, l_reg = 0; f32x16 o[4] = {}; f16x8 qr[8];
  const f16* Qw = Qb + (size_t)(wid * 32 + r32) * LDQ + hi * 8;
#pragma unroll
  for (int d0 = 0; d0 < 8; ++d0) qr[d0] = *reinterpret_cast<const f16x8*>(Qw + d0 * 16);
  const int sr = tid >> 4, sc = (tid & 15) * 8, vst0 = v_st(sr, sc), vst1 = v_st(32 + sr, sc);
  const int vb0 = (int)(uintptr_t)V_lds + v_rd_base(lane);
  struct { f16x8 vs0, vs1, ks0, ks1; } sr_[2];
#define TIDX(j) ((j) == 0 ? 0 : (tstart + (j)))
#define KROW(j) ({ int _t = TIDX(j); _t = _t < 0 ? 0 : (_t > Tmax ? Tmax : _t); _t * KVBLK; })
#define SLOAD(i, j) do { const int _k0 = KROW(j); sr_[i].vs0 = *(const f16x8*)&Vh[(size_t)(_k0 + sr) * LDQ + sc]; sr_[i].vs1 = *(const f16x8*)&Vh[(size_t)(_k0 + 32 + sr) * LDQ + sc]; \
    sr_[i].ks0 = *(const f16x8*)&Kh[(size_t)(_k0 + sr) * LDQ + sc]; sr_[i].ks1 = *(const f16x8*)&Kh[(size_t)(_k0 + 32 + sr) * LDQ + sc]; } while (0)
#define SWRITE(b, i) do { *(f16x8*)(V_lds + (b) * SHM_V + vst0) = sr_[i].vs0;          \
    *(f16x8*)(V_lds + (b) * SHM_V + vst1) = sr_[i].vs1; const int kc = sc * 2;               \
    *(f16x8*)(K_lds + (b) * SHM_K + KSWZ(sr, kc)) = sr_[i].ks0;                       \
    *(f16x8*)(K_lds + (b) * SHM_K + KSWZ(32 + sr, kc)) = sr_[i].ks1; } while (0)
#define SWAIT() asm volatile("s_waitcnt vmcnt(4)" ::: "memory")
#define RESC(a) do { if (__any((a) < 1.f)) { if (hi == 0) al_l[r32] = (a); asm volatile("s_waitcnt lgkmcnt(0)" ::: "memory"); \
    _Pragma("unroll") for (int d = 0; d < 4; ++d) _Pragma("unroll") for (int r = 0; r < 16; ++r) o[d][r] *= al_l[crow(r, hi)]; } } while (0)
#define MASKJ(P0, P1, j) do { if (MODE == 1) { const int _kb = (TIDX(j) - 1) * KVBLK; mask_tile(P0, P1, klo - _kb, khi - _kb, hi); } } while (0)
  f32x16 pA0, pA1, pB0, pB1; float mnA, mnB, alA, alB; f16x8 pa0, pa1, pa2, pa3;
  constexpr int SE = 0, SO = 1;
  SLOAD(SE, 0); asm volatile("s_waitcnt vmcnt(0)" ::: "memory"); SWRITE(0, SE); __syncthreads();
  qkt(pA0, pA1, K_lds, qr, r32, hi); mask_tile(pA0, pA1, 0, 15, hi); partialSM(pA0, pA1, m_reg, mnA, alA);
  SLOAD(SO, 1); if (2 < NT) SLOAD(SE, 2);
  SWAIT(); SWRITE(1, SO); __syncthreads();
  for (int j = 1; j + 1 < NT; j += 2) {
    SBAR(); qkt(pB0, pB1, K_lds + SHM_K, qr, r32, hi); MASKJ(pB0, pB1, j);
    finishSM(pA0, pA1, alA, l_reg, pa0, pa1, pa2, pa3); SBAR();
    SLOAD(SO, j + 2); SBAR();
    pv_d0(o, vb0, pa0, pa1, pa2, pa3); partialSM(pB0, pB1, m_reg, mnB, alB);
    __syncthreads(); SWAIT(); SWRITE(0, SE);
    RESC(alB); __syncthreads();
    SBAR(); qkt(pA0, pA1, K_lds, qr, r32, hi); MASKJ(pA0, pA1, j + 1);
    finishSM(pB0, pB1, alB, l_reg, pa0, pa1, pa2, pa3); SBAR();
    if (j + 3 < NT) SLOAD(SE, j + 3); SBAR();
    pv_d0(o, vb0 + SHM_V, pa0, pa1, pa2, pa3); partialSM(pA0, pA1, m_reg, mnA, alA);
    __syncthreads(); SWAIT(); SWRITE(1, SO);
    RESC(alA); __syncthreads();
  }
  SBAR(); qkt(pB0, pB1, K_lds + SHM_K, qr, r32, hi);
  if (MODE == 0) mask_tile(pB0, pB1, 1, 0, hi); else MASKJ(pB0, pB1, NT - 1);
  finishSM(pA0, pA1, alA, l_reg, pa0, pa1, pa2, pa3); SBAR();
  pv_d0(o, vb0, pa0, pa1, pa2, pa3); partialSM(pB0, pB1, m_reg, mnB, alB);
  __syncthreads(); RESC(alB);
  finishSM(pB0, pB1, alB, l_reg, pa0, pa1, pa2, pa3); SBAR();
  pv_d0(o, vb0 + SHM_V, pa0, pa1, pa2, pa3);
  if (MODE == 1) l_reg += __builtin_amdgcn_exp2f(sink * 1.4426950408889634f - m_reg * (ASCALE * 1.4426950408889634f));
  if (hi == 0) li_l[r32] = l_reg; asm volatile("s_waitcnt lgkmcnt(0)" ::: "memory");
  float rli[16];
#pragma unroll
  for (int r = 0; r < 16; ++r) rli[r] = __builtin_amdgcn_rcpf(li_l[crow(r, hi)]);
  f16* Ow = const_cast<f16*>(Qb) + (size_t)(wid * 32) * LDQ;
#pragma unroll
  for (int r = 0; r < 16; ++r) { const int orow = crow(r, hi);
    if (wid * 32 + orow < nvalid) {
#pragma unroll
      for (int d0 = 0; d0 < 4; ++d0) Ow[(size_t)orow * LDQ + d0 * 32 + r32] = (f16)(o[d0][r] * rli[r]); } }
  __syncthreads();
#undef SLOAD
#undef SWRITE
#undef SWAIT
#undef RESC
#undef MASKJ
#undef TIDX
#undef KROW
}

__device__ __forceinline__ void phase_attn(const Args& a, const Round& R, int l, unsigned* counter, char* lds) {
  f16* U = (f16*)(a.ws + WS_U);
  const int NQB = R.S / 256, per_seq = 8 * NQB;
  const int nreal = R.nseq * per_seq, nmeta = (l == 0) ? R.nseq * 8 : 0;
  const int total = 2 * (nreal + nmeta);
  const int tid_ = opaque_tid(); const int wid = tid_ >> 6, lane = tid_ & 63, r32 = lane & 31;
  const int qrow = wid * 32 + r32;
  unsigned* slot = (unsigned*)(lds + 131072);
  for (;;) {
    if (tid_ == 0) *slot = atomicAdd(counter, 1u);
    __syncthreads();
    const int idx = (int)*slot;
    __syncthreads();
    if (idx >= total) break;
    int modeB, meta, s, head, qb;
    if (idx < nreal) { modeB = 0; meta = 0; s = idx / per_seq; const int rem = idx - s * per_seq; head = rem / NQB; qb = rem - head * NQB; }
    else if (idx < nreal + nmeta) { modeB = 0; meta = 1; const int k = idx - nreal; s = k >> 3; head = k & 7; qb = 0; }
    else if (idx < 2 * nreal + nmeta) { modeB = 1; meta = 0; const int k = idx - nreal - nmeta; s = k / per_seq; const int rem = k - s * per_seq; head = rem / NQB; qb = rem - head * NQB; }
    else { modeB = 1; meta = 1; const int k = idx - 2 * nreal - nmeta; s = k >> 3; head = k & 7; qb = 0; }
    const size_t base = (size_t)s * R.SB;
    const size_t qrow0 = meta ? base : base + 64 + (size_t)qb * 256;
    const int Tmax = R.S / 64 + 1;
    if (!modeB) {
      const f16* Q = U + qrow0 * INW + C_QA + head * 128;
      const f16* K = U + base * INW + C_KA + (head >> 2) * 128;
      const f16* V = U + base * INW + C_VA + (head >> 2) * 128;
      attn_body<0>(Q, K, V, Tmax + 1, 0, Tmax, 0, 0, 0.f, meta ? 16 : 256, lds);
    } else {
      const f16* Q = U + qrow0 * INW + C_QB + head * 128;
      const f16* K = U + base * INW + C_KB + (head >> 2) * 128;
      const f16* V = U + base * INW + C_VB + (head >> 2) * 128;
      const float sink = a.sink[l * 8 + head];
      if (meta) { attn_body<1>(Q, K, V, 4, 0, Tmax, 0, qrow + 112, sink, 16, lds); }
      else { const int qi = qb * 256 + qrow; const int klo = qi - 128 < 0 ? 0 : qi - 128, khi = qi + 128 > R.S - 1 ? R.S - 1 : qi + 128;
        attn_body<1>(Q, K, V, 10, qb * 4 - 2, Tmax, klo, khi, sink, 256, lds); }
    }
  }
}

__global__ void __launch_bounds__(NTHR, 2) mega(Args a) {
  extern __shared__ __attribute__((aligned(16))) unsigned char lds[];
  cg::grid_group grid = cg::this_grid();
  phase_weights(a, (float*)lds);
  { const Round R0 = get_round(0); phase_rows(a, R0, 0, nullptr, nullptr, 0); }
  grid.sync();
  LAS unsigned char* ldsl = (LAS unsigned char*)lds;
  for (int r = 0; r < 4; ++r) {
    const Round R = get_round(r);
    const int nM = R.Mpad / 256;
    for (int l = 0; l < 2; ++l) {
      { Sched<1> S{a.ws, l, nM, (int)gridDim.x, (int)blockIdx.x}; EpiU E{a.ws}; gemm_phase<DM * 2, DM * 2, 16>(ldsl, S, E); }
      grid.sync();
      phase_prep(a, R, l);
      grid.sync();
      phase_attn(a, R, l, (unsigned*)(a.ws + WS_CTL) + (r * 2 + l) * 64, (char*)lds);
      grid.sync();
      { Sched<40> S{a.ws, l, nM, (int)gridDim.x, (int)blockIdx.x}; EpiGate<0> E{a.ws}; gemm_phase<INW * 2, DM * 2, 16>(ldsl, S, E); }
      { Sched<41> S{a.ws, l, nM, (int)gridDim.x, (int)blockIdx.x}; EpiGate<1> E{a.ws}; gemm_phase<INW * 2, DM * 2, 16>(ldsl, S, E); }
      { Sched<42> S{a.ws, l, nM, (int)gridDim.x, (int)blockIdx.x}; EpiGate<2> E{a.ws}; gemm_phase<DM * 2, 256 * 2, 4>(ldsl, S, E); }
      grid.sync();
      { Sched<5> S{a.ws, l, nM, (int)gridDim.x, (int)blockIdx.x}; EpiResid E{a.ws}; gemm_phase<DM * 2, DM * 2, 16>(ldsl, S, E); }
      grid.sync();
      phase_rows(a, R, 1, a.ln1g + l * DM, a.ln1b + l * DM, -1);
      grid.sync();
      { Sched<7> S{a.ws, l, nM, (int)gridDim.x, (int)blockIdx.x}; EpiSwiglu E{a.ws}; gemm_phase<DM * 2, DM * 2, 16>(ldsl, S, E); }
      grid.sync();
      { Sched<8> S{a.ws, l, nM, (int)gridDim.x, (int)blockIdx.x}; EpiResid E{a.ws}; gemm_phase<DFF * 2, DFF * 2, 44>(ldsl, S, E); }
      grid.sync();
      if (l == 0) phase_rows(a, R, 1, a.ln2g + l * DM, a.ln2b + l * DM, -1);
      else phase_rows(a, R, 2, a.ln2g + l * DM, a.ln2b + l * DM, r < 3 ? r + 1 : -1);
      grid.sync();
    }
  }
}

extern "C" void kernel_launch(void* const* d_in, const int* in_sizes, int n_in, void* d_out, int out_size, void* d_ws, size_t ws_size, hipStream_t stream) {
  static int grid_blocks = 0;
  if (grid_blocks == 0) {
    if (n_in != 18 || ws_size < WS_END) { fprintf(stderr, "kernel_launch: n_in %d ws %zu (need %zu)\n", n_in, ws_size, (size_t)WS_END); grid_blocks = -1; return; }
    int dev = 0, cus = 0, per_cu = 0;
    hipGetDevice(&dev);
    hipDeviceGetAttribute(&cus, hipDeviceAttributeMultiprocessorCount, dev);
    if (hipFuncSetAttribute((const void*)mega, hipFuncAttributeMaxDynamicSharedMemorySize, LDS_BYTES) != hipSuccess) { fprintf(stderr, "kernel_launch: hipFuncSetAttribute failed\n"); grid_blocks = -1; return; }
    hipOccupancyMaxActiveBlocksPerMultiprocessor(&per_cu, (const void*)mega, NTHR, LDS_BYTES);
    if (per_cu < 1) { fprintf(stderr, "kernel_launch: occupancy query gave %d\n", per_cu); per_cu = 1; }
    if (per_cu > 1) per_cu = 1;
    grid_blocks = cus * per_cu;
  }
  if (grid_blocks < 0) return;
  hipMemsetAsync((char*)d_ws + WS_CTL, 0, 4096, stream);
  Args a{};
  a.x_prompt = (const float*)d_in[0]; a.x_sample = (const float*)d_in[1]; a.meta = (const float*)d_in[2]; a.w_in = (const float*)d_in[3];
  a.qg = (const float*)d_in[4]; a.kg = (const float*)d_in[5]; a.sink = (const float*)d_in[6]; a.pool_w = (const float*)d_in[7]; a.pool_scale = (const float*)d_in[8];
  a.w_a = (const float*)d_in[9]; a.w_b = (const float*)d_in[10]; a.w_out = (const float*)d_in[11]; a.ln1g = (const float*)d_in[12]; a.ln1b = (const float*)d_in[13];
  a.w_up = (const float*)d_in[14]; a.w_down = (const float*)d_in[15]; a.ln2g = (const float*)d_in[16]; a.ln2b = (const float*)d_in[17];
  a.out = (float*)d_out; a.ws = (unsigned char*)d_ws;
  void* args[] = {&a};
  hipError_t e = hipLaunchCooperativeKernel((const void*)mega, dim3(grid_blocks), dim3(NTHR), args, LDS_BYTES, stream);
  if (e != hipSuccess) fprintf(stderr, "cooperative launch failed: %s (grid %d)\n", hipGetErrorString(e), grid_blocks);
}
```

```cpp
#include <hip/hip_runtime.h>
#include <hip/hip_cooperative_groups.h>
#include <cstdio>
namespace cg = cooperative_groups;

#define LAS __attribute__((address_space(3)))
typedef _Float16 f16;
typedef _Float16 f16x8 __attribute__((ext_vector_type(8)));
typedef _Float16 f16x4 __attribute__((ext_vector_type(4)));
typedef _Float16 f16x2 __attribute__((ext_vector_type(2)));
typedef float f32x4 __attribute__((ext_vector_type(4)));
typedef float f32x16 __attribute__((ext_vector_type(16)));
typedef unsigned u32x4 __attribute__((ext_vector_type(4)));
typedef unsigned u32x2 __attribute__((ext_vector_type(2)));

__device__ __forceinline__ int opaque_tid() { int t = threadIdx.x; asm volatile("" : "+v"(t)); return t; }

constexpr int DM = 1024, INW = 7168, DFF = 2816, NUP = 5632;
constexpr int MROWS = 16896;
constexpr int C_QA = 0, C_KA = 1024, C_VA = 1280, C_QB = 1536, C_KB = 2560, C_VB = 2816, C_UC = 3072, C_UG = 4096;
constexpr float ALPHA = 1.4142135623730951f;
constexpr int NTHR = 512;

constexpr size_t WS_CTL = 0;
constexpr size_t WS_BAR = 4096;
constexpr size_t CTL_BYTES = 32768;
constexpr size_t WS_WIN = CTL_BYTES;
constexpr size_t WS_WA  = WS_WIN + (size_t)2 * INW * DM * 2;
constexpr size_t WS_WB  = WS_WA + (size_t)2 * DM * DM * 2;
constexpr size_t WS_WO  = WS_WB + (size_t)2 * DM * DM * 2;
constexpr size_t WS_WP  = WS_WO + (size_t)2 * DM * DM * 2;
constexpr size_t WS_WUP = WS_WP + (size_t)2 * 4 * 256 * 256 * 2;
constexpr size_t WS_WDN = WS_WUP + (size_t)2 * NUP * DM * 2;
constexpr size_t WS_U   = WS_WDN + (size_t)2 * DM * DFF * 2;
constexpr size_t WS_PD  = WS_U + (size_t)(MROWS + 256) * INW * 2;
constexpr size_t WS_MG  = WS_PD + (size_t)MROWS * DM * 2;
constexpr size_t WS_H16 = WS_MG + (size_t)MROWS * DM * 2;
constexpr size_t WS_H32 = WS_H16 + (size_t)MROWS * DM * 2;
constexpr size_t WS_END = WS_H32 + (size_t)MROWS * DM * 4;
constexpr int LDS_BYTES = 131072 + 256;

struct Args {
  const float* x_prompt; const float* x_sample; const float* meta; const float* w_in; const float* qg; const float* kg; const float* sink;
  const float* pool_w; const float* pool_scale; const float* w_a; const float* w_b; const float* w_out; const float* ln1g; const float* ln1b;
  const float* w_up; const float* w_down; const float* ln2g; const float* ln2b;
  float* out; unsigned char* ws; int dry_on; int pad;
};

struct Round { int nseq, S, SB, Mpad, is_sample, b0; };
__device__ __forceinline__ Round get_round(int r) {
  Round R;
  if (r < 2) { R.nseq = 4; R.S = 4096; R.SB = 4224; R.Mpad = 16896; R.is_sample = 0; R.b0 = r * 4; }
  else       { R.nseq = 1; R.S = 16384; R.SB = 16512; R.Mpad = 16640; R.is_sample = 1; R.b0 = r - 2; }
  return R;
}

#define XB_TMO      128
#define XB_XCNT(j)  (256  + 64 * (j))
#define XB_XSUB(j)  (1280 + 64 * (j))
#define XB_XGEN(j)  (2304 + 64 * (j))
#define XB_TOP      3328
#define XB_TOPGEN   3392
#define XCD_BAR_WORDS 3456
#define XB_SPIN_CAP (1u << 22)
__device__ __forceinline__ unsigned xb_ld(unsigned* p)              { return __hip_atomic_load(p, __ATOMIC_RELAXED, __HIP_MEMORY_SCOPE_AGENT); }
__device__ __forceinline__ unsigned xb_add(unsigned* p, unsigned v) { return __hip_atomic_fetch_add(p, v, __ATOMIC_RELAXED, __HIP_MEMORY_SCOPE_AGENT); }
__device__ __forceinline__ unsigned xb_xcc_id() { return (unsigned)__builtin_amdgcn_s_getreg((3 << 11) | 20) & 0xFu; }
#define XB_SPIN(cond, bar) do { unsigned _sp = 0; while (cond) { __builtin_amdgcn_s_sleep(1); \
    if ((++_sp & 255u) == 0u) { if (xb_ld(&(bar)[XB_TMO])) break; if (_sp > XB_SPIN_CAP) { atomicAdd(&(bar)[XB_TMO], 1u); break; } } } } while (0)
struct XcdBarrier { unsigned* bar; unsigned x; volatile LAS unsigned* st; };
__device__ __forceinline__ XcdBarrier xcd_barrier_post(unsigned* bar, volatile LAS unsigned* st) {
  XcdBarrier b; b.bar = bar; b.x = xb_xcc_id(); b.st = st;
  if (threadIdx.x == 0) (void)xb_add(&bar[XB_XCNT(b.x)], 1u);
  return b;
}
__device__ __forceinline__ void xcd_barrier_complete(unsigned* bar, unsigned x, unsigned& nloc, unsigned& nx) {
  const unsigned G = gridDim.x * gridDim.y * gridDim.z;
  unsigned sum, cnt, mine, sp = 0u;
  for (;;) {
    sum = 0u; cnt = 0u; mine = 0u;
#pragma unroll
    for (unsigned j = 0; j < 16; ++j) { const unsigned c = xb_ld(&bar[XB_XCNT(j)]); sum += c; cnt += (c > 0u) ? 1u : 0u; mine = (j == x) ? c : mine; }
    if (sum == G) break;
    __builtin_amdgcn_s_sleep(1);
    if ((++sp & 255u) == 0u) { if (xb_ld(&bar[XB_TMO])) break; if (sp > XB_SPIN_CAP) { atomicAdd(&bar[XB_TMO], 1u); break; } }
  }
  nloc = mine > 0u ? mine : 1u; nx = cnt > 0u ? cnt : 1u;
}
__device__ __forceinline__ void xcd_barrier(const XcdBarrier& b) {
  asm volatile("s_waitcnt vmcnt(0)" ::: "memory");
  __syncthreads();
  if (threadIdx.x == 0) {
    unsigned* bar = b.bar;
    __builtin_amdgcn_s_waitcnt(0);
    unsigned nloc = b.st[0], nx = b.st[1];
    if (nloc == 0u) { xcd_barrier_complete(bar, b.x, nloc, nx); b.st[0] = nloc; b.st[1] = nx; }
    const unsigned old = xb_add(&bar[XB_XSUB(b.x)], 1u);
    const unsigned gen = old / nloc;
    if (old + 1u == (gen + 1u) * nloc) {
      __builtin_amdgcn_fence(__ATOMIC_RELEASE, "agent");
      asm volatile("s_waitcnt vmcnt(0)" ::: "memory");
      const unsigned og = xb_add(&bar[XB_TOP], 1u);
      const unsigned tg = og / nx;
      if (og + 1u == (tg + 1u) * nx) xb_add(&bar[XB_TOPGEN], 1u);
      else XB_SPIN(xb_ld(&bar[XB_TOPGEN]) == tg, bar);
      __builtin_amdgcn_fence(__ATOMIC_ACQUIRE, "agent");
      xb_add(&bar[XB_XGEN(b.x)], 1u);
      asm volatile("s_waitcnt vmcnt(0)" ::: "memory");
    } else {
      XB_SPIN(xb_ld(&bar[XB_XGEN(b.x)]) == gen, bar);
      __builtin_amdgcn_fence(__ATOMIC_ACQUIRE, "agent");
      asm volatile("s_waitcnt vmcnt(0)" ::: "memory");
    }
  }
  __syncthreads();
}

__device__ __forceinline__ void tp_tile(const float* __restrict__ src, int lds_, int k0, int n0, f16* __restrict__ dst, int ldd, int drow0,
                                        const float* __restrict__ scale, float* tile) {
  const int t = opaque_tid();
#pragma unroll
  for (int p = 0; p < 2; ++p) {
    const int r = (t >> 4) + 32 * p, c4 = (t & 15) * 4;
    const f32x4 v = *(const f32x4*)(src + (size_t)(k0 + r) * lds_ + n0 + c4);
    tile[r * 65 + c4 + 0] = v[0]; tile[r * 65 + c4 + 1] = v[1]; tile[r * 65 + c4 + 2] = v[2]; tile[r * 65 + c4 + 3] = v[3];
  }
  __syncthreads();
  {
    const int n = t >> 3, k8 = (t & 7) * 8;
    const float sc = scale ? scale[n0 + n] : 1.0f;
    f16x8 o;
#pragma unroll
    for (int i = 0; i < 8; ++i) o[i] = (f16)(tile[(k8 + i) * 65 + n] * sc);
    *(f16x8*)(dst + (size_t)(drow0 + n) * ldd + k0 + k8) = o;
  }
  __syncthreads();
}

__device__ __forceinline__ void phase_weights(const Args& a, float* tile) {
  constexpr int T_IN = 16 * 112, T_SQ = 16 * 16, T_UP = 16 * 88, T_DN = 44 * 16, T_PL = 4 * 16;
  constexpr int T_LAYER = T_IN + 3 * T_SQ + T_UP + T_DN + T_PL;
  unsigned char* ws = a.ws;
  for (int idx = blockIdx.x; idx < 2 * T_LAYER; idx += gridDim.x) {
    const int l = idx / T_LAYER; int j = idx % T_LAYER;
    if (j < T_IN) { const int kt = j / 112, nt = j % 112;
      tp_tile(a.w_in + (size_t)l * DM * INW, INW, kt * 64, nt * 64, (f16*)(ws + WS_WIN) + (size_t)l * INW * DM, DM, nt * 64, nullptr, tile); continue; }
    j -= T_IN;
    if (j < 3 * T_SQ) { const int w = j / T_SQ, jj = j % T_SQ, kt = jj / 16, nt = jj % 16;
      const float* src = (w == 0 ? a.w_a : (w == 1 ? a.w_b : a.w_out)) + (size_t)l * DM * DM;
      f16* dst = (f16*)(ws + (w == 0 ? WS_WA : (w == 1 ? WS_WB : WS_WO))) + (size_t)l * DM * DM;
      tp_tile(src, DM, kt * 64, nt * 64, dst, DM, nt * 64, nullptr, tile); continue; }
    j -= 3 * T_SQ;
    if (j < T_UP) { const int kt = j / 88, nt = j % 88; const int n0 = nt * 64, bj = n0 / DFF, rem = n0 % DFF, p = rem / 128, j0 = rem % 128;
      tp_tile(a.w_up + (size_t)l * DM * NUP, NUP, kt * 64, n0, (f16*)(ws + WS_WUP) + (size_t)l * NUP * DM, DM, p * 256 + bj * 128 + j0, nullptr, tile); continue; }
    j -= T_UP;
    if (j < T_DN) { const int kt = j / 16, nt = j % 16;
      tp_tile(a.w_down + (size_t)l * DFF * DM, DM, kt * 64, nt * 64, (f16*)(ws + WS_WDN) + (size_t)l * DM * DFF, DFF, nt * 64, nullptr, tile); continue; }
    j -= T_DN;
    { const int g = j / 16, jj = j % 16, kt = jj / 4, nt = jj % 4;
      tp_tile(a.pool_w + ((size_t)l * 4 + g) * 256 * 256, 256, kt * 64, nt * 64, (f16*)(ws + WS_WP) + ((size_t)l * 4 + g) * 256 * 256, 256, nt * 64,
              a.pool_scale + (size_t)l * DM + g * 256, tile); }
  }
}

__device__ __forceinline__ int row_kind(const Round& R, int row, int& s, int& o) {
  if (row >= R.nseq * R.SB) return 0;
  s = row / R.SB; const int q = row - s * R.SB;
  if (q < 16) { o = q; return 1; }
  if (q < 64) return 0;
  if (q < 64 + R.S) { o = q - 64; return 2; }
  return 0;
}
__device__ __forceinline__ const float* x_row(const Args& a, const Round& R, int s, int i) {
  return R.is_sample ? a.x_sample + ((size_t)R.b0 * 16384 + i) * DM : a.x_prompt + ((size_t)(R.b0 + s) * 4096 + i) * DM;
}
__device__ __forceinline__ float* out_row(const Args& a, const Round& R, int s, int i) {
  return R.is_sample ? a.out + (size_t)8 * 4096 * DM + ((size_t)R.b0 * 16384 + i) * DM : a.out + ((size_t)(R.b0 + s) * 4096 + i) * DM;
}
__device__ __forceinline__ void store_h(const Args& a, int row, int lane, const f32x4 (&v)[4]) {
  float* h32 = (float*)(a.ws + WS_H32) + (size_t)row * DM; f16* h16 = (f16*)(a.ws + WS_H16) + (size_t)row * DM;
#pragma unroll
  for (int i = 0; i < 4; ++i) { const int c = i * 256 + lane * 4;
    *(f32x4*)(h32 + c) = v[i];
    f16x4 h = {(f16)v[i][0], (f16)v[i][1], (f16)v[i][2], (f16)v[i][3]}; *(f16x4*)(h16 + c) = h; }
}
__device__ __forceinline__ void init_row(const Args& a, const Round& R, int row, int lane) {
  int s = 0, o = 0; const int kd = row_kind(R, row, s, o);
  f32x4 v[4];
  const float* src = kd == 1 ? a.meta + (size_t)o * DM : (kd == 2 ? x_row(a, R, s, o) : nullptr);
#pragma unroll
  for (int i = 0; i < 4; ++i) v[i] = src ? *(const f32x4*)(src + i * 256 + lane * 4) : (f32x4){0.f, 0.f, 0.f, 0.f};
  store_h(a, row, lane, v);
}
__device__ __forceinline__ void ln_row(const Args& a, const Round& R, int row, int lane, const float* __restrict__ g, const float* __restrict__ b, int to_out, int dry) {
  const float* h32 = (const float*)(a.ws + WS_H32) + (size_t)row * DM;
  f32x4 v[4]; float s = 0.f;
#pragma unroll
  for (int i = 0; i < 4; ++i) { v[i] = *(const f32x4*)(h32 + i * 256 + lane * 4); s += (v[i][0] + v[i][1]) + (v[i][2] + v[i][3]); }
#pragma unroll
  for (int o = 32; o >= 1; o >>= 1) s += __shfl_xor(s, o);
  const float mu = s * (1.0f / DM); float q = 0.f;
#pragma unroll
  for (int i = 0; i < 4; ++i) { const f32x4 d = v[i] - mu; q += (d[0] * d[0] + d[1] * d[1]) + (d[2] * d[2] + d[3] * d[3]); }
#pragma unroll
  for (int o = 32; o >= 1; o >>= 1) q += __shfl_xor(q, o);
  const float rstd = 1.0f / sqrtf(q * (1.0f / DM) + 1e-5f);
#pragma unroll
  for (int i = 0; i < 4; ++i) { const f32x4 gg = *(const f32x4*)(g + i * 256 + lane * 4), bb = *(const f32x4*)(b + i * 256 + lane * 4); v[i] = (v[i] - mu) * rstd * gg + bb; }
  if (dry) return;
  if (!to_out) { store_h(a, row, lane, v); return; }
  int sq = 0, o = 0; const int kd = row_kind(R, row, sq, o);
  if (kd == 2) { float* dst = out_row(a, R, sq, o);
#pragma unroll
    for (int i = 0; i < 4; ++i) *(f32x4*)(dst + i * 256 + lane * 4) = v[i]; }
}
__device__ __forceinline__ void phase_rows(const Args& a, const Round& R, int mode, const float* g, const float* b, int rn, int dry = 0) {
  const int tid_ = opaque_tid(); const int wid = tid_ >> 6, lane = tid_ & 63;
  const int nw = gridDim.x * 8;
  if (mode != 0) for (int row = blockIdx.x * 8 + wid; row < R.Mpad; row += nw) ln_row(a, R, row, lane, g, b, mode == 2, dry);
  if (mode == 1 || rn < 0 || dry) return;
  const Round Rn = get_round(rn);
  for (int row = blockIdx.x * 8 + wid; row < MROWS; row += nw) { if (row < Rn.Mpad) init_row(a, Rn, row, lane); }
}

constexpr int BM = 256, BK = 64, HALF = 128, HTB = HALF * BK * 2, NXCD = 8, WGM = 8;
__device__ __forceinline__ int lds_byte(int r, int c) { const int st = (r >> 4) * 2 + (c >> 5), rr = r & 15, cc = c & 31, ob = rr * 64 + cc * 2; return st * 1024 + (ob ^ (((ob >> 9) & 1) << 5)); }
__device__ __forceinline__ void stage_rc(int b, int& R, int& C) { const int st = b / 1024, sb = b % 1024, swz = sb ^ (((sb >> 9) & 1) << 5); R = (st >> 1) * 16 + swz / 64; C = (st & 1) * 32 + (swz % 64) / 2; }

struct GUnit { const char* A; const char* B; int pm, pn; };

__device__ __forceinline__ void tile_map(int L, int nM, int nN, int& pm, int& pn) {
  const int nwg = nM * nN; int wgid = L;
  { const int q = nwg / NXCD, r = nwg % NXCD, xcd = wgid % NXCD, off = wgid / NXCD; wgid = (xcd < r ? xcd * (q + 1) : r * (q + 1) + (xcd - r) * q) + off; }
  const int nig = WGM * nN, gid = wgid / nig, fm = gid * WGM, gsz = (nM - fm) < WGM ? (nM - fm) : WGM;
  pm = fm + ((wgid % nig) % gsz); pn = (wgid % nig) / gsz;
}

template <int LDA2, int LDB2, int NT, class Sched, class Epi>
__device__ __forceinline__ void gemm_phase(LAS unsigned char* lds, const Sched& S, const Epi& E) {
  const int tid = opaque_tid(), wid = __builtin_amdgcn_readfirstlane(tid >> 6), lane = tid & 63, wr = wid >> 2, wc = wid & 3, fr = lane & 15, fq = lane >> 4;
  unsigned voffA[2], voffB[2];
#pragma unroll
  for (int i = 0; i < 2; ++i) { int R, C; stage_rc(tid * 16 + i * 8192, R, C); voffA[i] = (unsigned)(R * LDA2 + C * 2); voffB[i] = (unsigned)(R * LDB2 + C * 2); }
  constexpr size_t kstep = (size_t)(BK * 2);
  constexpr size_t hA = (size_t)HALF * LDA2, hB = (size_t)HALF * LDB2;
  const unsigned ldsw = (unsigned)wid * 1024u;
  const int aoff = lds_byte(wr * 64 + fr, fq * 8), boff = lds_byte(wc * 32 + fr, fq * 8);
#define G_SA(b, h) (((b) * 2 + (h)) * HTB)
#define G_SB(b, h) ((4 + (b) * 2 + (h)) * HTB)
#define G_STAGE(bufoff, gbase, voff) do { _Pragma("unroll") for (int _i = 0; _i < 2; ++_i) \
    __builtin_amdgcn_global_load_lds((const unsigned*)((const char*)(gbase) + (voff)[_i]), (LAS unsigned*)(lds + (bufoff) + ldsw + _i * 8192), 16, 0, 0); } while (0)
#define G_LDA(dst, b, h) do { _Pragma("unroll") for (int m = 0; m < 4; ++m) _Pragma("unroll") for (int k = 0; k < 2; ++k) dst[m][k] = *(const LAS f16x8*)(lds + G_SA(b, h) + aoff + m * 2048 + k * 1024); } while (0)
#define G_LDB(dst, b, h) do { _Pragma("unroll") for (int n = 0; n < 2; ++n) _Pragma("unroll") for (int k = 0; k < 2; ++k) dst[n][k] = *(const LAS f16x8*)(lds + G_SB(b, h) + boff + n * 2048 + k * 1024); } while (0)
#define G_MMA(ai, bj, At, Bt) do { __builtin_amdgcn_s_setprio(1); _Pragma("unroll") for (int m = 0; m < 4; ++m) _Pragma("unroll") for (int n = 0; n < 2; ++n) _Pragma("unroll") for (int k = 0; k < 2; ++k) \
    acc[ai][bj][m][n] = __builtin_amdgcn_mfma_f32_16x16x32_f16(Bt[n][k], At[m][k], acc[ai][bj][m][n], 0, 0, 0); __builtin_amdgcn_s_setprio(0); } while (0)
#define G_WAIT_V(n) asm volatile("s_waitcnt vmcnt(" #n ")" ::: "memory")
#define G_WAIT_L(n) asm volatile("s_waitcnt lgkmcnt(" #n ")" ::: "memory")
#define G_BAR __builtin_amdgcn_s_barrier()
#define G_SCHED __builtin_amdgcn_sched_barrier(0)
  GUnit cur, nxt; int ui = 0;
  if (!S.next(0, cur)) return;
  f32x4 acc[2][2][4][2];
#pragma unroll
  for (int a = 0; a < 2; ++a)
#pragma unroll
    for (int b = 0; b < 2; ++b)
#pragma unroll
      for (int m = 0; m < 4; ++m)
#pragma unroll
        for (int n = 0; n < 2; ++n) acc[a][b][m][n] = (f32x4){0.f, 0.f, 0.f, 0.f};
  f16x8 At[4][2], B0[2][2], B1[2][2];
  const char* cA = cur.A; const char* cB = cur.B;
  G_STAGE(G_SB(0, 0), cB, voffB); G_STAGE(G_SA(0, 0), cA, voffA); G_STAGE(G_SB(0, 1), cB + hB, voffB); G_STAGE(G_SA(0, 1), cA + hA, voffA);
  if (wr == 1) G_BAR;
  G_WAIT_V(4); G_BAR;
  G_STAGE(G_SB(1, 0), cB + kstep, voffB); G_STAGE(G_SA(1, 0), cA + kstep, voffA); G_STAGE(G_SB(1, 1), cB + hB + kstep, voffB);
  G_WAIT_V(6); G_BAR;
  for (;;) {
    const bool has_next = S.next(ui + 1, nxt);
    const char* nA = has_next ? nxt.A : cA; const char* nB = has_next ? nxt.B : cB;
#pragma unroll 1
    for (int t = 0; t < NT; t += 2) {
      const bool last = (t == NT - 2);
      const char* a1 = cA + (size_t)(t + 1) * kstep;
      const char* a2 = last ? nA : cA + (size_t)(t + 2) * kstep; const char* b2 = last ? nB : cB + (size_t)(t + 2) * kstep;
      const char* a3 = a2 + kstep; const char* b3 = b2 + kstep;
      G_LDB(B0, 0, 0); G_SCHED; G_LDA(At, 0, 0); G_STAGE(G_SA(1, 1), a1 + hA, voffA);
      G_WAIT_L(8); G_BAR; G_WAIT_L(0); G_MMA(0, 0, At, B0); G_BAR; G_SCHED;
      G_LDB(B1, 0, 1); G_STAGE(G_SB(0, 0), b2, voffB);
      G_BAR; G_WAIT_L(0); G_MMA(0, 1, At, B1); G_BAR;
      G_LDA(At, 0, 1); G_STAGE(G_SA(0, 0), a2, voffA);
      G_BAR; G_WAIT_L(0); G_MMA(1, 0, At, B0); G_BAR; G_SCHED;
      G_STAGE(G_SB(0, 1), b2 + hB, voffB);
      G_WAIT_V(6); G_BAR; G_MMA(1, 1, At, B1); G_BAR;
      G_LDB(B0, 1, 0); G_SCHED; G_LDA(At, 1, 0); G_STAGE(G_SA(0, 1), a2 + hA, voffA);
      G_WAIT_L(8); G_BAR; G_WAIT_L(0); G_MMA(0, 0, At, B0); G_BAR; G_SCHED;
      G_LDB(B1, 1, 1); G_STAGE(G_SB(1, 0), b3, voffB);
      G_BAR; G_WAIT_L(0); G_MMA(0, 1, At, B1); G_BAR;
      G_LDA(At, 1, 1); G_STAGE(G_SA(1, 0), a3, voffA);
      G_BAR; G_WAIT_L(0); G_MMA(1, 0, At, B0); G_BAR; G_SCHED;
      G_STAGE(G_SB(1, 1), b3 + hB, voffB);
      G_WAIT_V(6); G_BAR; G_MMA(1, 1, At, B1); G_BAR;
    }
    E(acc, cur, wr, wc, fr, fq);
    if (!has_next) break;
#pragma unroll
    for (int a = 0; a < 2; ++a)
#pragma unroll
      for (int b = 0; b < 2; ++b)
#pragma unroll
        for (int m = 0; m < 4; ++m)
#pragma unroll
          for (int n = 0; n < 2; ++n) acc[a][b][m][n] = (f32x4){0.f, 0.f, 0.f, 0.f};
    cur = nxt; cA = nA; cB = nB; ++ui;
  }
  G_WAIT_V(0);
  if (wr == 0) G_BAR;
  G_BAR;
#undef G_SA
#undef G_SB
#undef G_STAGE
#undef G_LDA
#undef G_LDB
#undef G_MMA
#undef G_WAIT_V
#undef G_WAIT_L
#undef G_BAR
#undef G_SCHED
}

template <int PH> struct Sched {
  const unsigned char* ws; int l, nM, G, c;
  __device__ __forceinline__ bool next(int i, GUnit& u) const {
    constexpr int nN = PH == 1 ? 28 : (PH == 7 ? 22 : 4);
    const long L = (long)i * G + c; if (L >= (long)nM * nN) return false;
    int pm, pn; tile_map((int)L, nM, nN, pm, pn);
    u.pm = pm; u.pn = pn;
    if (PH == 1)  { u.A = (const char*)(ws + WS_H16) + (size_t)pm * 256 * DM * 2; u.B = (const char*)(ws + WS_WIN) + ((size_t)l * INW + (size_t)pn * 256) * DM * 2; }
    if (PH == 40) { u.A = (const char*)(ws + WS_U) + ((size_t)pm * 256 * INW + C_QA) * 2; u.B = (const char*)(ws + WS_WA) + ((size_t)l * DM + (size_t)pn * 256) * DM * 2; }
    if (PH == 41) { u.A = (const char*)(ws + WS_U) + ((size_t)pm * 256 * INW + C_QB) * 2; u.B = (const char*)(ws + WS_WB) + ((size_t)l * DM + (size_t)pn * 256) * DM * 2; }
    if (PH == 42) { u.A = (const char*)(ws + WS_PD) + ((size_t)pm * 256 * DM + pn * 256) * 2; u.B = (const char*)(ws + WS_WP) + ((size_t)l * 4 + pn) * 256 * 256 * 2; }
    if (PH == 5)  { u.A = (const char*)(ws + WS_MG) + (size_t)pm * 256 * DM * 2; u.B = (const char*)(ws + WS_WO) + ((size_t)l * DM + (size_t)pn * 256) * DM * 2; }
    if (PH == 7)  { u.A = (const char*)(ws + WS_H16) + (size_t)pm * 256 * DM * 2; u.B = (const char*)(ws + WS_WUP) + ((size_t)l * NUP + (size_t)pn * 256) * DM * 2; }
    if (PH == 8)  { u.A = (const char*)(ws + WS_U) + (size_t)pm * 256 * DFF * 2; u.B = (const char*)(ws + WS_WDN) + ((size_t)l * DM + (size_t)pn * 256) * DFF * 2; }
    return true;
  }
};

__device__ __forceinline__ f16x4 to_h4(f32x4 v) { f16x4 h = {(f16)v[0], (f16)v[1], (f16)v[2], (f16)v[3]}; return h; }
__device__ __forceinline__ f32x4 to_f4(f16x4 h) { f32x4 v = {(float)h[0], (float)h[1], (float)h[2], (float)h[3]}; return v; }
struct EpiU { int dry;
  unsigned char* ws;
  __device__ __forceinline__ void operator()(const f32x4 (&acc)[2][2][4][2], const GUnit& u, int wr, int wc, int fr, int fq) const {
    if (dry) return;
    f16* U = (f16*)(ws + WS_U);
    const int row0 = u.pm * BM + wr * 64 + fr, col0 = u.pn * BM + wc * 32 + 4 * fq;
#pragma unroll
    for (int ai = 0; ai < 2; ++ai)
#pragma unroll
      for (int m = 0; m < 4; ++m) { f16* rowp = U + (size_t)(row0 + ai * HALF + m * 16) * INW + col0;
#pragma unroll
        for (int bj = 0; bj < 2; ++bj)
#pragma unroll
          for (int n = 0; n < 2; ++n) *(f16x4*)(rowp + bj * HALF + n * 16) = to_h4(acc[ai][bj][m][n]); }
  }
};
template <int KIND> struct EpiGate { int dry;
  unsigned char* ws;
  __device__ __forceinline__ void operator()(const f32x4 (&acc)[2][2][4][2], const GUnit& u, int wr, int wc, int fr, int fq) const {
    if (dry) return;
    const f16* U = (const f16*)(ws + WS_U); f16* MG = (f16*)(ws + WS_MG);
    const int row0 = u.pm * BM + wr * 64 + fr, col0 = u.pn * BM + wc * 32 + 4 * fq;
    constexpr int kind = KIND;
#pragma unroll
    for (int ai = 0; ai < 2; ++ai)
#pragma unroll
      for (int m = 0; m < 4; ++m) { const size_t row = (size_t)(row0 + ai * HALF + m * 16);
        const f16* gp = U + row * INW + C_UG + kind * DM + col0; f16* mp = MG + row * DM + col0;
#pragma unroll
        for (int bj = 0; bj < 2; ++bj)
#pragma unroll
          for (int n = 0; n < 2; ++n) { const f32x4 g = to_f4(*(const f16x4*)(gp + bj * HALF + n * 16)); f32x4 v = acc[ai][bj][m][n];
#pragma unroll
            for (int j = 0; j < 4; ++j) v[j] = v[j] / (1.0f + __expf(-g[j]));
            if (kind != 0) v += to_f4(*(const f16x4*)(mp + bj * HALF + n * 16));
            *(f16x4*)(mp + bj * HALF + n * 16) = to_h4(v); } }
  }
};
struct EpiResid { int dry;
  unsigned char* ws;
  __device__ __forceinline__ void operator()(const f32x4 (&acc)[2][2][4][2], const GUnit& u, int wr, int wc, int fr, int fq) const {
    if (dry) return;
    float* H = (float*)(ws + WS_H32);
    const int row0 = u.pm * BM + wr * 64 + fr, col0 = u.pn * BM + wc * 32 + 4 * fq;
#pragma unroll
    for (int ai = 0; ai < 2; ++ai)
#pragma unroll
      for (int m = 0; m < 4; ++m) { float* rowp = H + (size_t)(row0 + ai * HALF + m * 16) * DM + col0;
#pragma unroll
        for (int bj = 0; bj < 2; ++bj)
#pragma unroll
          for (int n = 0; n < 2; ++n) { const f32x4 o = *(const f32x4*)(rowp + bj * HALF + n * 16); *(f32x4*)(rowp + bj * HALF + n * 16) = o * ALPHA + acc[ai][bj][m][n]; } }
  }
};
struct EpiSwiglu { int dry;
  unsigned char* ws;
  __device__ __forceinline__ void operator()(const f32x4 (&acc)[2][2][4][2], const GUnit& u, int wr, int wc, int fr, int fq) const {
    if (dry) return;
    f16* HID = (f16*)(ws + WS_U);
    const int row0 = u.pm * BM + wr * 64 + fr, col0 = u.pn * HALF + wc * 32 + 4 * fq;
#pragma unroll
    for (int ai = 0; ai < 2; ++ai)
#pragma unroll
      for (int m = 0; m < 4; ++m) { f16* rowp = HID + (size_t)(row0 + ai * HALF + m * 16) * DFF + col0;
#pragma unroll
        for (int n = 0; n < 2; ++n) { const f32x4 g = acc[ai][0][m][n], up = acc[ai][1][m][n]; f32x4 v;
#pragma unroll
          for (int j = 0; j < 4; ++j) v[j] = g[j] / (1.0f + __expf(-g[j])) * up[j];
          *(f16x4*)(rowp + n * 16) = to_h4(v); } }
  }
};

__device__ __forceinline__ float wave_sum(float s) {
#pragma unroll
  for (int o = 32; o >= 1; o >>= 1) s += __shfl_xor(s, o);
  return s;
}
__device__ __forceinline__ void sincos_turns(float ang, float& sn, float& cs) {
  const double t = (double)ang * 0.15915494309189533577;
  const float fr = (float)(t - floor(t));
  sn = __builtin_amdgcn_sinf(fr); cs = __builtin_amdgcn_cosf(fr);
}
__device__ __forceinline__ void phase_prep(const Args& a, const Round& R, int l, int dry) {
  const int tid_ = opaque_tid(); const int wid = tid_ >> 6, lane = tid_ & 63;
  f16* U = (f16*)(a.ws + WS_U); f16* PD = (f16*)(a.ws + WS_PD);
  const int L = R.S + 16, ntok = R.nseq * L;
  const int iA = lane & 31, secA = lane >> 5;
  const int dA1 = secA * 64 + iA, dA2 = dA1 + 32;
  const int dB1 = lane, dB2 = lane + 64;
  const float invA = (float)exp2(-(double)(2 * iA) / 64.0 * 13.287712379549449);
  const float invB = (float)exp2(-(double)(2 * lane) / 128.0 * 13.287712379549449);
  const float gq1 = a.qg[l * 128 + dA1], gq2 = a.qg[l * 128 + dA2], gk1 = a.kg[l * 128 + dA1], gk2 = a.kg[l * 128 + dA2];
  const int pg = lane >> 4, win = 2 << pg, c0 = lane * 16;
  for (int tok = blockIdx.x * 8 + wid; tok < ntok; tok += gridDim.x * 8) {
    const int s = tok / L, t = tok - s * L;
    const int base = s * R.SB;
    const int row = base + (t < 16 ? t : t + 48);
    f16* up = U + (size_t)row * INW;
    int prow, pcol;
    if (t < 16) { prow = -1; pcol = t; } else { const int i = t - 16; prow = i >> 6; pcol = i & 63; }
    float snA, csA, snB, csB;
    sincos_turns((float)(secA ? pcol : prow) * invA, snA, csA);
    sincos_turns((float)t * invB, snB, csB);
#pragma unroll
    for (int h = 0; h < 10; ++h) {
      f16* p = up + (h < 8 ? C_QA + h * 128 : C_KA + (h - 8) * 128);
      float x1 = (float)p[dA1], x2 = (float)p[dA2];
      const float ss = wave_sum(x1 * x1 + x2 * x2);
      const float rs = 1.0f / sqrtf(ss * (1.0f / 128.0f) + 1e-6f);
      x1 = x1 * rs * (h < 8 ? gq1 : gk1); x2 = x2 * rs * (h < 8 ? gq2 : gk2);
      if (!dry) { p[dA1] = (f16)(x1 * csA - x2 * snA); p[dA2] = (f16)(x1 * snA + x2 * csA); }
    }
#pragma unroll
    for (int h = 0; h < 10; ++h) {
      f16* p = up + (h < 8 ? C_QB + h * 128 : C_KB + (h - 8) * 128);
      const float x1 = (float)p[dB1], x2 = (float)p[dB2];
      if (!dry) { p[dB1] = (f16)(x1 * csB - x2 * snB); p[dB2] = (f16)(x1 * snB + x2 * csB); }
    }
    {
      int lo = t - win / 2; int hi = lo + win; lo = lo < 0 ? 0 : lo; hi = hi > L ? L : hi;
      float acc[16];
#pragma unroll
      for (int j = 0; j < 16; ++j) acc[j] = 0.f;
      for (int tt = lo; tt < hi; ++tt) {
        const f16* q = U + (size_t)(base + (tt < 16 ? tt : tt + 48)) * INW + C_UC + c0;
        const f16x8 v0 = *(const f16x8*)q, v1 = *(const f16x8*)(q + 8);
#pragma unroll
        for (int j = 0; j < 8; ++j) { acc[j] += (float)v0[j]; acc[8 + j] += (float)v1[j]; }
      }
      const float rc = 1.0f / (float)(hi - lo);
      const f16x8 s0 = *(const f16x8*)(up + C_UC + c0), s1 = *(const f16x8*)(up + C_UC + c0 + 8);
      f16x8 o0, o1;
#pragma unroll
      for (int j = 0; j < 8; ++j) { o0[j] = (f16)(acc[j] * rc - (float)s0[j]); o1[j] = (f16)(acc[8 + j] * rc - (float)s1[j]); }
      if (!dry) { *(f16x8*)(PD + (size_t)row * DM + c0) = o0; *(f16x8*)(PD + (size_t)row * DM + c0 + 8) = o1; }
    }
  }
}

constexpr int AD = 128, KVBLK = 64, LDQ = INW;
constexpr float ASCALE = 0.088388347648318440f;
constexpr float ATHR = 8.f;
constexpr int SHM_V = KVBLK * AD * 2, SHM_K = KVBLK * AD * 2;
typedef short s16x4 __attribute__((ext_vector_type(4)));
#define KSWZ(row, colB) ((row) * 256 + ((colB) ^ (((row) & 7) << 4)))
#define SBAR() __builtin_amdgcn_sched_barrier(0)
__device__ __forceinline__ int crow(int r, int hi) { return (r & 3) + 8 * (r >> 2) + 4 * hi; }
__device__ __forceinline__ unsigned cvtpk(float lo, float hi) { f16x2 v = {(f16)lo, (f16)hi}; return __builtin_bit_cast(unsigned, v); }

__device__ __forceinline__ void partialSM(f32x16& p0, f32x16& p1, float& m_reg, float& mn, float& alpha) {
  constexpr float C = ASCALE * 1.4426950408889634f;
  float pmax = p0[0];
#pragma unroll
  for (int r = 1; r < 16; ++r) pmax = fmaxf(pmax, p0[r]);
#pragma unroll
  for (int r = 0; r < 16; ++r) pmax = fmaxf(pmax, p1[r]);
  { auto rr = __builtin_amdgcn_permlane32_swap(__float_as_uint(pmax), __float_as_uint(pmax), false, false);
    pmax = fmaxf(__uint_as_float(rr[0]), __uint_as_float(rr[1])); }
  if (__builtin_expect(__all(pmax - m_reg <= ATHR / ASCALE), 1)) { mn = m_reg; alpha = 1.f; }
  else { mn = fmaxf(m_reg, pmax); alpha = __builtin_amdgcn_exp2f((m_reg - mn) * C); m_reg = mn; }
  const float mnC = -mn * C;
#pragma unroll
  for (int r = 0; r < 16; ++r) p0[r] = fmaf(p0[r], C, mnC);
#pragma unroll
  for (int r = 0; r < 16; ++r) p1[r] = fmaf(p1[r], C, mnC);
#pragma unroll
  for (int r = 0; r < 16; ++r) p0[r] = __builtin_amdgcn_exp2f(p0[r]);
}
__device__ __forceinline__ void finishSM(f32x16& p0, f32x16& p1, float alpha, float& l_reg, f16x8& pa0, f16x8& pa1, f16x8& pa2, f16x8& pa3) {
#pragma unroll
  for (int r = 0; r < 16; ++r) p1[r] = __builtin_amdgcn_exp2f(p1[r]);
  float ps = 0;
#pragma unroll
  for (int r = 0; r < 16; ++r) ps += p0[r];
#pragma unroll
  for (int r = 0; r < 16; ++r) ps += p1[r];
  { auto rr = __builtin_amdgcn_permlane32_swap(__float_as_uint(ps), __float_as_uint(ps), false, false);
    ps = __uint_as_float(rr[0]) + __uint_as_float(rr[1]); }
  l_reg = l_reg * alpha + ps;
#define PK4(P, BASE, OUT) do { unsigned a0 = cvtpk(P[BASE + 0], P[BASE + 1]), a1 = cvtpk(P[BASE + 2], P[BASE + 3]);   \
    unsigned b0 = cvtpk(P[BASE + 4], P[BASE + 5]), b1 = cvtpk(P[BASE + 6], P[BASE + 7]);                              \
    auto r0 = __builtin_amdgcn_permlane32_swap(a0, b0, false, false); auto r1 = __builtin_amdgcn_permlane32_swap(a1, b1, false, false); \
    u32x4 w = {r0[0], r1[0], r0[1], r1[1]}; OUT = __builtin_bit_cast(f16x8, w); } while (0)
  PK4(p0, 0, pa0); PK4(p0, 8, pa1); PK4(p1, 0, pa2); PK4(p1, 8, pa3);
#undef PK4
}
__device__ __forceinline__ void qkt(f32x16& p0, f32x16& p1, const char* Ks, const f16x8* qr, int r32, int hi) {
  p0 = f32x16{}; p1 = f32x16{};
#pragma unroll
  for (int d0 = 0; d0 < 8; ++d0) { const int cb = (d0 * 16 + hi * 8) * 2;
    const f16x8 b0 = *reinterpret_cast<const f16x8*>(Ks + KSWZ(r32, cb));
    const f16x8 b1 = *reinterpret_cast<const f16x8*>(Ks + KSWZ(32 + r32, cb));
    p0 = __builtin_amdgcn_mfma_f32_32x32x16_f16(b0, qr[d0], p0, 0, 0, 0);
    p1 = __builtin_amdgcn_mfma_f32_32x32x16_f16(b1, qr[d0], p1, 0, 0, 0); }
}
__device__ __forceinline__ void mask_tile(f32x16& p0, f32x16& p1, int ka, int kb, int hi) {
  const int a2 = ka - 4 * hi; const unsigned span = (unsigned)(kb - ka);
#pragma unroll
  for (int r = 0; r < 16; ++r) { const int c = (r & 3) + 8 * (r >> 2);
    p0[r] = ((unsigned)(c - a2) <= span && kb >= ka) ? p0[r] : -1e30f;
    p1[r] = ((unsigned)(c + 32 - a2) <= span && kb >= ka) ? p1[r] : -1e30f; }
}
__device__ __forceinline__ int v_st(int k, int c) { const int kk = (k & ~0xC) | ((k & 4) << 1) | ((k & 8) >> 1); return ((kk >> 3) * 4 + (c >> 5)) * 512 + ((kk & 7) * 32 + (c & 31)) * 2; }
__device__ __forceinline__ int v_rd_base(int lane) { return ((lane & 3) << 3) | (((lane >> 2) & 3) << 6) | (((lane >> 4) & 1) << 5) | (((lane >> 5) & 1) << 8); }
constexpr int v_rd_off(int d0, int ks, int half) { return d0 * 512 + ks * 4096 + half * 2048; }
template <int OFF> __device__ __forceinline__ s16x4 tr_read(int vb) {
  s16x4 r; asm volatile("ds_read_b64_tr_b16 %0, %1 offset:%2" : "=&v"(r) : "v"(vb), "i"(OFF) : "memory"); return r;
}
template <int D0> __device__ __forceinline__ void pv_one(f32x16& od, int vb, f16x8 pa0, f16x8 pa1, f16x8 pa2, f16x8 pa3) {
  const s16x4 l0 = tr_read<v_rd_off(D0, 0, 0)>(vb), h0 = tr_read<v_rd_off(D0, 0, 1)>(vb), l1 = tr_read<v_rd_off(D0, 1, 0)>(vb), h1 = tr_read<v_rd_off(D0, 1, 1)>(vb);
  const s16x4 l2 = tr_read<v_rd_off(D0, 2, 0)>(vb), h2 = tr_read<v_rd_off(D0, 2, 1)>(vb), l3 = tr_read<v_rd_off(D0, 3, 0)>(vb), h3 = tr_read<v_rd_off(D0, 3, 1)>(vb);
  asm volatile("s_waitcnt lgkmcnt(0)" ::: "memory"); SBAR();
  typedef short s16x8 __attribute__((ext_vector_type(8)));
#define PK(L, H) __builtin_bit_cast(f16x8, (s16x8){L[0], L[1], L[2], L[3], H[0], H[1], H[2], H[3]})
  od = __builtin_amdgcn_mfma_f32_32x32x16_f16(pa0, PK(l0, h0), od, 0, 0, 0);
  od = __builtin_amdgcn_mfma_f32_32x32x16_f16(pa1, PK(l1, h1), od, 0, 0, 0);
  od = __builtin_amdgcn_mfma_f32_32x32x16_f16(pa2, PK(l2, h2), od, 0, 0, 0);
  od = __builtin_amdgcn_mfma_f32_32x32x16_f16(pa3, PK(l3, h3), od, 0, 0, 0);
#undef PK
}
__device__ __forceinline__ void pv_d0(f32x16* o, int vb, f16x8 pa0, f16x8 pa1, f16x8 pa2, f16x8 pa3) {
  pv_one<0>(o[0], vb, pa0, pa1, pa2, pa3); pv_one<1>(o[1], vb, pa0, pa1, pa2, pa3); pv_one<2>(o[2], vb, pa0, pa1, pa2, pa3); pv_one<3>(o[3], vb, pa0, pa1, pa2, pa3);
}

template <int MODE>
__device__ __forceinline__ void attn_body(const f16* Qb, const f16* __restrict__ Kh, const f16* __restrict__ Vh, int NT, int tstart, int Tmax,
                                          int klo, int khi, float sink, int nvalid, char* lds) {
  const int tid = opaque_tid(), wid = tid >> 6, lane = tid & 63, r32 = lane & 31, hi = lane >> 5;
  char* V_lds = lds; char* K_lds = lds + 2 * SHM_V;
  float* wsf = (float*)(lds + 2 * SHM_V + 2 * SHM_K) + wid * 64; float* li_l = wsf; float* al_l = wsf + 32;
  float m_reg = -1e30f, l_reg = 0; f32x16 o[4] = {}; f16x8 qr[8];
  const f16* Qw = Qb + (size_t)(wid * 32 + r32) * LDQ + hi * 8;
#pragma unroll
  for (int d0 = 0; d0 < 8; ++d0) qr[d0] = *reinterpret_cast<const f16x8*>(Qw + d0 * 16);
  const int sr = tid >> 4, sc = (tid & 15) * 8, vst0 = v_st(sr, sc), vst1 = v_st(32 + sr, sc);
  const int vb0 = (int)(uintptr_t)V_lds + v_rd_base(lane);
  struct { f16x8 vs0, vs1, ks0, ks1; } sr_[2];
#define TIDX(j) ((j) == 0 ? 0 : (tstart + (j)))
#define KROW(j) ({ int _t = TIDX(j); _t = _t < 0 ? 0 : (_t > Tmax ? Tmax : _t); _t * KVBLK; })
#define SLOAD(i, j) do { const int _k0 = KROW(j); sr_[i].vs0 = *(const f16x8*)&Vh[(size_t)(_k0 + sr) * LDQ + sc]; sr_[i].vs1 = *(const f16x8*)&Vh[(size_t)(_k0 + 32 + sr) * LDQ + sc]; \
    sr_[i].ks0 = *(const f16x8*)&Kh[(size_t)(_k0 + sr) * LDQ + sc]; sr_[i].ks1 = *(const f16x8*)&Kh[(size_t)(_k0 + 32 + sr) * LDQ + sc]; } while (0)
#define SWRITE(b, i) do { *(f16x8*)(V_lds + (b) * SHM_V + vst0) = sr_[i].vs0;          \
    *(f16x8*)(V_lds + (b) * SHM_V + vst1) = sr_[i].vs1; const int kc = sc * 2;               \
    *(f16x8*)(K_lds + (b) * SHM_K + KSWZ(sr, kc)) = sr_[i].ks0;                       \
    *(f16x8*)(K_lds + (b) * SHM_K + KSWZ(32 + sr, kc)) = sr_[i].ks1; } while (0)
#define SWAIT() asm volatile("s_waitcnt vmcnt(4)" ::: "memory")
#define RESC(a) do { if (__any((a) < 1.f)) { if (hi == 0) al_l[r32] = (a); asm volatile("s_waitcnt lgkmcnt(0)" ::: "memory"); \
    _Pragma("unroll") for (int d = 0; d < 4; ++d) _Pragma("unroll") for (int r = 0; r < 16; ++r) o[d][r] *= al_l[crow(r, hi)]; } } while (0)
#define MASKJ(P0, P1, j) do { if (MODE == 1) { const int _kb = (TIDX(j) - 1) * KVBLK; mask_tile(P0, P1, klo - _kb, khi - _kb, hi); } } while (0)
  f32x16 pA0, pA1, pB0, pB1; float mnA, mnB, alA, alB; f16x8 pa0, pa1, pa2, pa3;
  constexpr int SE = 0, SO = 1;
  SLOAD(SE, 0); asm volatile("s_waitcnt vmcnt(0)" ::: "memory"); SWRITE(0, SE); __syncthreads();
  qkt(pA0, pA1, K_lds, qr, r32, hi); mask_tile(pA0, pA1, 0, 15, hi); partialSM(pA0, pA1, m_reg, mnA, alA);
  SLOAD(SO, 1); if (2 < NT) SLOAD(SE, 2);
  SWAIT(); SWRITE(1, SO); __syncthreads();
  for (int j = 1; j + 1 < NT; j += 2) {
    SBAR(); qkt(pB0, pB1, K_lds + SHM_K, qr, r32, hi); MASKJ(pB0, pB1, j);
    finishSM(pA0, pA1, alA, l_reg, pa0, pa1, pa2, pa3); SBAR();
    SLOAD(SO, j + 2); SBAR();
    pv_d0(o, vb0, pa0, pa1, pa2, pa3); partialSM(pB0, pB1, m_reg, mnB, alB);
    __syncthreads(); SWAIT(); SWRITE(0, SE);
    RESC(alB); __syncthreads();
    SBAR(); qkt(pA0, pA1, K_lds, qr, r32, hi); MASKJ(pA0, pA1, j + 1);
    finishSM(pB0, pB1, alB, l_reg, pa0, pa1, pa2, pa3); SBAR();
    if (j + 3 < NT) SLOAD(SE, j + 3); SBAR();
    pv_d0(o, vb0 + SHM_V, pa0, pa1, pa2, pa3); partialSM(pA0, pA1, m_reg, mnA, alA);
    __syncthreads(); SWAIT(); SWRITE(1, SO);
    RESC(alA); __syncthreads();
  }
  SBAR(); qkt(pB0, pB1, K_lds + SHM_K, qr, r32, hi);
  if (MODE == 0) mask_tile(pB0, pB1, 1, 0, hi); else MASKJ(pB0, pB1, NT - 1);
  finishSM(pA0, pA1, alA, l_reg, pa0, pa1, pa2, pa3); SBAR();
  pv_d0(o, vb0, pa0, pa1, pa2, pa3); partialSM(pB0, pB1, m_reg, mnB, alB);
  __syncthreads(); RESC(alB);
  finishSM(pB0, pB1, alB, l_reg, pa0, pa1, pa2, pa3); SBAR();
  pv_d0(o, vb0 + SHM_V, pa0, pa1, pa2, pa3);
  if (MODE == 1) l_reg += __builtin_amdgcn_exp2f(sink * 1.4426950408889634f - m_reg * (ASCALE * 1.4426950408889634f));
  if (hi == 0) li_l[r32] = l_reg; asm volatile("s_waitcnt lgkmcnt(0)" ::: "memory");
  float rli[16];
#pragma unroll
  for (int r = 0; r < 16; ++r) rli[r] = __builtin_amdgcn_rcpf(li_l[crow(r, hi)]);
  f16* Ow = const_cast<f16*>(Qb) + (size_t)(wid * 32) * LDQ;
#pragma unroll
  for (int r = 0; r < 16; ++r) { const int orow = crow(r, hi);
    if (wid * 32 + orow < nvalid) {
#pragma unroll
      for (int d0 = 0; d0 < 4; ++d0) Ow[(size_t)orow * LDQ + d0 * 32 + r32] = (f16)(o[d0][r] * rli[r]); } }
  __syncthreads();
#undef SLOAD
#undef SWRITE
#undef SWAIT
#undef RESC
#undef MASKJ
#undef TIDX
#undef KROW
}

__device__ __forceinline__ void phase_attn(const Args& a, const Round& R, int l, unsigned* counter, char* lds, int dry) {
  f16* U = (f16*)(a.ws + WS_U);
  const int NQB = R.S / 256, per_seq = 8 * NQB;
  const int nreal = R.nseq * per_seq, nmeta = (l == 0) ? R.nseq * 8 : 0;
  const int total = 2 * (nreal + nmeta);
  const int tid_ = opaque_tid(); const int wid = tid_ >> 6, lane = tid_ & 63, r32 = lane & 31;
  const int qrow = wid * 32 + r32;
  unsigned* slot = (unsigned*)(lds + 131072);
  for (;;) {
    if (tid_ == 0) *slot = atomicAdd(counter, 1u);
    __syncthreads();
    const int idx = (int)*slot;
    __syncthreads();
    if (idx >= total) break;
    int modeB, meta, s, head, qb;
    if (idx < nreal) { modeB = 0; meta = 0; s = idx / per_seq; const int rem = idx - s * per_seq; head = rem / NQB; qb = rem - head * NQB; }
    else if (idx < nreal + nmeta) { modeB = 0; meta = 1; const int k = idx - nreal; s = k >> 3; head = k & 7; qb = 0; }
    else if (idx < 2 * nreal + nmeta) { modeB = 1; meta = 0; const int k = idx - nreal - nmeta; s = k / per_seq; const int rem = k - s * per_seq; head = rem / NQB; qb = rem - head * NQB; }
    else { modeB = 1; meta = 1; const int k = idx - 2 * nreal - nmeta; s = k >> 3; head = k & 7; qb = 0; }
    const size_t base = (size_t)s * R.SB;
    const size_t qrow0 = meta ? base : base + 64 + (size_t)qb * 256;
    const int Tmax = R.S / 64 + 1;
    if (!modeB) {
      const f16* Q = U + qrow0 * INW + C_QA + head * 128;
      const f16* K = U + base * INW + C_KA + (head >> 2) * 128;
      const f16* V = U + base * INW + C_VA + (head >> 2) * 128;
      attn_body<0>(Q, K, V, Tmax + 1, 0, Tmax, 0, 0, 0.f, dry ? 0 : (meta ? 16 : 256), lds);
    } else {
      const f16* Q = U + qrow0 * INW + C_QB + head * 128;
      const f16* K = U + base * INW + C_KB + (head >> 2) * 128;
      const f16* V = U + base * INW + C_VB + (head >> 2) * 128;
      const float sink = a.sink[l * 8 + head];
      if (meta) { attn_body<1>(Q, K, V, 4, 0, Tmax, 0, qrow + 112, sink, dry ? 0 : 16, lds); }
      else { const int qi = qb * 256 + qrow; const int klo = qi - 128 < 0 ? 0 : qi - 128, khi = qi + 128 > R.S - 1 ? R.S - 1 : qi + 128;
        attn_body<1>(Q, K, V, 10, qb * 4 - 2, Tmax, klo, khi, sink, dry ? 0 : 256, lds); }
    }
  }
}

#ifndef PROBE
#define PROBE 0
#endif
__global__ void __launch_bounds__(NTHR, 2) mega(Args a) {
  extern __shared__ __attribute__((aligned(16))) unsigned char lds[];
  cg::grid_group grid = cg::this_grid();
  volatile LAS unsigned* bst = (volatile LAS unsigned*)((LAS unsigned char*)lds + 131072 + 64);
  if (threadIdx.x < 2) bst[threadIdx.x] = 0u;
  __syncthreads();
  const XcdBarrier xbar = xcd_barrier_post((unsigned*)(a.ws + WS_BAR), bst);
  phase_weights(a, (float*)lds);
  { const Round R0 = get_round(0); phase_rows(a, R0, 0, nullptr, nullptr, 0); }
  grid.sync();
  LAS unsigned char* ldsl = (LAS unsigned char*)lds;
  for (int r = 0; r < 4; ++r) {
    const Round R = get_round(r);
    const int nM = R.Mpad / 256;
    for (int l = 0; l < 2; ++l) {
      { Sched<1> S{a.ws, l, nM, (int)gridDim.x, (int)blockIdx.x}; EpiU E{0, a.ws}; gemm_phase<DM * 2, DM * 2, 16>(ldsl, S, E);
        if (PROBE == 1) gemm_phase<DM * 2, DM * 2, 16>(ldsl, S, E); }
      xcd_barrier(xbar);
      phase_prep(a, R, l, 0);
      if (PROBE == 3) phase_prep(a, R, l, a.dry_on);
      xcd_barrier(xbar);
      phase_attn(a, R, l, (unsigned*)(a.ws + WS_CTL) + (r * 2 + l) * 64, (char*)lds, 0);
      if (PROBE == 2) phase_attn(a, R, l, (unsigned*)(a.ws + WS_CTL) + (r * 2 + l) * 64 + 32, (char*)lds, a.dry_on);
      xcd_barrier(xbar);
      for (int rep = 0; rep < (PROBE == 1 ? 2 : 1); ++rep) {
      { Sched<40> S{a.ws, l, nM, (int)gridDim.x, (int)blockIdx.x}; EpiGate<0> E{0, a.ws}; gemm_phase<INW * 2, DM * 2, 16>(ldsl, S, E); }
      { Sched<41> S{a.ws, l, nM, (int)gridDim.x, (int)blockIdx.x}; EpiGate<1> E{0, a.ws}; gemm_phase<INW * 2, DM * 2, 16>(ldsl, S, E); }
      { Sched<42> S{a.ws, l, nM, (int)gridDim.x, (int)blockIdx.x}; EpiGate<2> E{0, a.ws}; gemm_phase<DM * 2, 256 * 2, 4>(ldsl, S, E); }
      }
      xcd_barrier(xbar);
      { Sched<5> S{a.ws, l, nM, (int)gridDim.x, (int)blockIdx.x}; EpiResid E{0, a.ws}; gemm_phase<DM * 2, DM * 2, 16>(ldsl, S, E);
        if (PROBE == 1) { E.dry = a.dry_on; gemm_phase<DM * 2, DM * 2, 16>(ldsl, S, E); } }
      xcd_barrier(xbar);
      phase_rows(a, R, 1, a.ln1g + l * DM, a.ln1b + l * DM, -1);
      if (PROBE == 3) phase_rows(a, R, 1, a.ln1g + l * DM, a.ln1b + l * DM, -1, a.dry_on);
      xcd_barrier(xbar);
      { Sched<7> S{a.ws, l, nM, (int)gridDim.x, (int)blockIdx.x}; EpiSwiglu E{0, a.ws}; gemm_phase<DM * 2, DM * 2, 16>(ldsl, S, E);
        if (PROBE == 1) gemm_phase<DM * 2, DM * 2, 16>(ldsl, S, E); }
      xcd_barrier(xbar);
      { Sched<8> S{a.ws, l, nM, (int)gridDim.x, (int)blockIdx.x}; EpiResid E{0, a.ws}; gemm_phase<DFF * 2, DFF * 2, 44>(ldsl, S, E);
        if (PROBE == 1) { E.dry = a.dry_on; gemm_phase<DFF * 2, DFF * 2, 44>(ldsl, S, E); } }
      xcd_barrier(xbar);
      if (PROBE == 3) phase_rows(a, R, 1, a.ln2g + l * DM, a.ln2b + l * DM, -1, a.dry_on);
      if (l == 0) phase_rows(a, R, 1, a.ln2g + l * DM, a.ln2b + l * DM, -1);
      else phase_rows(a, R, 2, a.ln2g + l * DM, a.ln2b + l * DM, r < 3 ? r + 1 : -1);
      xcd_barrier(xbar);
    }
  }
}

extern "C" void kernel_launch(void* const* d_in, const int* in_sizes, int n_in, void* d_out, int out_size, void* d_ws, size_t ws_size, hipStream_t stream) {
  static int grid_blocks = 0;
  if (grid_blocks == 0) {
    if (n_in != 18 || ws_size < WS_END) { fprintf(stderr, "kernel_launch: n_in %d ws %zu (need %zu)\n", n_in, ws_size, (size_t)WS_END); grid_blocks = -1; return; }
    int dev = 0, cus = 0, per_cu = 0;
    hipGetDevice(&dev);
    hipDeviceGetAttribute(&cus, hipDeviceAttributeMultiprocessorCount, dev);
    if (hipFuncSetAttribute((const void*)mega, hipFuncAttributeMaxDynamicSharedMemorySize, LDS_BYTES) != hipSuccess) { fprintf(stderr, "kernel_launch: hipFuncSetAttribute failed\n"); grid_blocks = -1; return; }
    hipOccupancyMaxActiveBlocksPerMultiprocessor(&per_cu, (const void*)mega, NTHR, LDS_BYTES);
    if (per_cu < 1) { fprintf(stderr, "kernel_launch: occupancy query gave %d\n", per_cu); per_cu = 1; }
    if (per_cu > 1) per_cu = 1;
    grid_blocks = cus * per_cu;
  }
  if (grid_blocks < 0) return;
  (void)hipMemsetAsync((char*)d_ws + WS_CTL, 0, CTL_BYTES, stream);
  Args a{};
  a.x_prompt = (const float*)d_in[0]; a.x_sample = (const float*)d_in[1]; a.meta = (const float*)d_in[2]; a.w_in = (const float*)d_in[3];
  a.qg = (const float*)d_in[4]; a.kg = (const float*)d_in[5]; a.sink = (const float*)d_in[6]; a.pool_w = (const float*)d_in[7]; a.pool_scale = (const float*)d_in[8];
  a.w_a = (const float*)d_in[9]; a.w_b = (const float*)d_in[10]; a.w_out = (const float*)d_in[11]; a.ln1g = (const float*)d_in[12]; a.ln1b = (const float*)d_in[13];
  a.w_up = (const float*)d_in[14]; a.w_down = (const float*)d_in[15]; a.ln2g = (const float*)d_in[16]; a.ln2b = (const float*)d_in[17];
  a.out = (float*)d_out; a.ws = (unsigned char*)d_ws; a.dry_on = 1; a.pad = 0;
  void* args[] = {&a};
  hipError_t e = hipLaunchCooperativeKernel((const void*)mega, dim3(grid_blocks), dim3(NTHR), args, LDS_BYTES, stream);
  if (e != hipSuccess) fprintf(stderr, "cooperative launch failed: %s (grid %d)\n", hipGetErrorString(e), grid_blocks);
}
```

```cpp
#include <hip/hip_runtime.h>
#include <hip/hip_cooperative_groups.h>
#include <cstdio>
namespace cg = cooperative_groups;

#define LAS __attribute__((address_space(3)))
typedef _Float16 f16;
typedef _Float16 f16x8 __attribute__((ext_vector_type(8)));
typedef _Float16 f16x4 __attribute__((ext_vector_type(4)));
typedef _Float16 f16x2 __attribute__((ext_vector_type(2)));
typedef float f32x4 __attribute__((ext_vector_type(4)));
typedef float f32x16 __attribute__((ext_vector_type(16)));
typedef unsigned u32x4 __attribute__((ext_vector_type(4)));
typedef unsigned u32x2 __attribute__((ext_vector_type(2)));

__device__ __forceinline__ int opaque_tid(int swid) { int t = swid * 64 + (int)__builtin_amdgcn_mbcnt_hi(~0u, __builtin_amdgcn_mbcnt_lo(~0u, 0u)); asm volatile("" : "+v"(t)); return t; }

constexpr int DM = 1024, INW = 7168, DFF = 2816, NUP = 5632;
constexpr int RB = 128;
constexpr int MROWS = RB + 16384;
constexpr int C_QA = 0, C_KA = 1024, C_VA = 1280, C_QB = 1536, C_KB = 2560, C_VB = 2816, C_UC = 3072, C_UG = 4096;
constexpr float ALPHA = 1.4142135623730951f;
constexpr int NTHR = 512;

constexpr size_t WS_CTL = 0;
constexpr size_t WS_BAR = 4096;
constexpr size_t CTL_BYTES = 32768;
constexpr size_t WS_WIN = CTL_BYTES;
constexpr size_t WS_WA  = WS_WIN + (size_t)2 * INW * DM * 2;
constexpr size_t WS_WB  = WS_WA + (size_t)2 * DM * DM * 2;
constexpr size_t WS_WO  = WS_WB + (size_t)2 * DM * DM * 2;
constexpr size_t WS_WP  = WS_WO + (size_t)2 * DM * DM * 2;
constexpr size_t WS_WUP = WS_WP + (size_t)2 * 4 * 256 * 256 * 2;
constexpr size_t WS_WDN = WS_WUP + (size_t)2 * NUP * DM * 2;
constexpr size_t WS_U   = WS_WDN + (size_t)2 * DM * DFF * 2;
constexpr size_t WS_PD  = WS_U + (size_t)MROWS * INW * 2;
constexpr size_t WS_MG  = WS_PD + (size_t)MROWS * DM * 2;
constexpr size_t WS_H16 = WS_MG + (size_t)MROWS * DM * 2;
constexpr size_t WS_H32 = WS_H16 + (size_t)MROWS * DM * 2;
constexpr size_t WS_PART = WS_H32 + (size_t)MROWS * DM * 4;
constexpr size_t WS_END = WS_PART + (size_t)352 * 2080 * 4;
constexpr int LDS_BYTES = 131072 + 256;

struct Args {
  const float* x_prompt; const float* x_sample; const float* meta; const float* w_in; const float* qg; const float* kg; const float* sink;
  const float* pool_w; const float* pool_scale; const float* w_a; const float* w_b; const float* w_out; const float* ln1g; const float* ln1b;
  const float* w_up; const float* w_down; const float* ln2g; const float* ln2b;
  float* out; unsigned char* ws; int dry_on; int pad;
};

struct Round { int nseq, S, is_sample, b0; };
__device__ __forceinline__ Round get_round(int r) {
  Round R;
  if (r < 2) { R.nseq = 4; R.S = 4096; R.is_sample = 0; R.b0 = r * 4; }
  else       { R.nseq = 1; R.S = 16384; R.is_sample = 1; R.b0 = r & 1; }
  return R;
}

#define XB_TMO      128
#define XB_XCNT(j)  (256  + 64 * (j))
#define XB_XSUB(j)  (1280 + 64 * (j))
#define XB_XGEN(j)  (2304 + 64 * (j))
#define XB_TOP      3328
#define XB_TOPGEN   3392
#define XCD_BAR_WORDS 3456
#define XB_SPIN_CAP (1u << 22)
__device__ __forceinline__ unsigned xb_ld(unsigned* p)              { return __hip_atomic_load(p, __ATOMIC_RELAXED, __HIP_MEMORY_SCOPE_AGENT); }
__device__ __forceinline__ unsigned xb_add(unsigned* p, unsigned v) { return __hip_atomic_fetch_add(p, v, __ATOMIC_RELAXED, __HIP_MEMORY_SCOPE_AGENT); }
__device__ __forceinline__ unsigned xb_xcc_id() { return (unsigned)__builtin_amdgcn_s_getreg((3 << 11) | 20) & 0xFu; }
#define XB_SPIN(cond, bar) do { unsigned _sp = 0; while (cond) { __builtin_amdgcn_s_sleep(1); \
    if ((++_sp & 255u) == 0u) { if (xb_ld(&(bar)[XB_TMO])) break; if (_sp > XB_SPIN_CAP) { atomicAdd(&(bar)[XB_TMO], 1u); break; } } } } while (0)
struct XcdBarrier { unsigned* bar; unsigned x; volatile LAS unsigned* st; };
__device__ __forceinline__ XcdBarrier xcd_barrier_post(unsigned* bar, volatile LAS unsigned* st, int tid) {
  XcdBarrier b; b.bar = bar; b.x = xb_xcc_id(); b.st = st;
  if (tid == 0) (void)xb_add(&bar[XB_XCNT(b.x)], 1u);
  return b;
}
__device__ __forceinline__ void xcd_barrier_complete(unsigned* bar, unsigned x, unsigned& nloc, unsigned& nx) {
  const unsigned G = gridDim.x * gridDim.y * gridDim.z;
  unsigned sum, cnt, mine, sp = 0u;
  for (;;) {
    sum = 0u; cnt = 0u; mine = 0u;
#pragma unroll
    for (unsigned j = 0; j < 16; ++j) { const unsigned c = xb_ld(&bar[XB_XCNT(j)]); sum += c; cnt += (c > 0u) ? 1u : 0u; mine = (j == x) ? c : mine; }
    if (sum == G) break;
    __builtin_amdgcn_s_sleep(1);
    if ((++sp & 255u) == 0u) { if (xb_ld(&bar[XB_TMO])) break; if (sp > XB_SPIN_CAP) { atomicAdd(&bar[XB_TMO], 1u); break; } }
  }
  nloc = mine > 0u ? mine : 1u; nx = cnt > 0u ? cnt : 1u;
}
__device__ __forceinline__ void xcd_barrier(const XcdBarrier& b, int swid) {
  asm volatile("s_waitcnt vmcnt(0)" ::: "memory");
  __syncthreads();
  if (opaque_tid(swid) == 0) {
    unsigned* bar = b.bar;
    __builtin_amdgcn_s_waitcnt(0);
    unsigned nloc = b.st[0], nx = b.st[1];
    if (nloc == 0u) { xcd_barrier_complete(bar, b.x, nloc, nx); b.st[0] = nloc; b.st[1] = nx; }
    const unsigned old = xb_add(&bar[XB_XSUB(b.x)], 1u);
    const unsigned gen = old / nloc;
    if (old + 1u == (gen + 1u) * nloc) {
      __builtin_amdgcn_fence(__ATOMIC_RELEASE, "agent");
      asm volatile("s_waitcnt vmcnt(0)" ::: "memory");
      const unsigned og = xb_add(&bar[XB_TOP], 1u);
      const unsigned tg = og / nx;
      if (og + 1u == (tg + 1u) * nx) xb_add(&bar[XB_TOPGEN], 1u);
      else XB_SPIN(xb_ld(&bar[XB_TOPGEN]) == tg, bar);
      __builtin_amdgcn_fence(__ATOMIC_ACQUIRE, "agent");
      xb_add(&bar[XB_XGEN(b.x)], 1u);
      asm volatile("s_waitcnt vmcnt(0)" ::: "memory");
    } else {
      XB_SPIN(xb_ld(&bar[XB_XGEN(b.x)]) == gen, bar);
      __builtin_amdgcn_fence(__ATOMIC_ACQUIRE, "agent");
      asm volatile("s_waitcnt vmcnt(0)" ::: "memory");
    }
  }
  __syncthreads();
}

__device__ __forceinline__ void tp_tile(const float* __restrict__ src, int lds_, int k0, int n0, f16* __restrict__ dst, int ldd, int drow0,
                                        const float* __restrict__ scale, float* tile, int swid) {
  const int t = opaque_tid(swid);
#pragma unroll
  for (int p = 0; p < 2; ++p) {
    const int r = (t >> 4) + 32 * p, c4 = (t & 15) * 4;
    const f32x4 v = *(const f32x4*)(src + (size_t)(k0 + r) * lds_ + n0 + c4);
    tile[r * 65 + c4 + 0] = v[0]; tile[r * 65 + c4 + 1] = v[1]; tile[r * 65 + c4 + 2] = v[2]; tile[r * 65 + c4 + 3] = v[3];
  }
  __syncthreads();
  {
    const int n = t >> 3, k8 = (t & 7) * 8;
    const float sc = scale ? scale[n0 + n] : 1.0f;
    f16x8 o;
#pragma unroll
    for (int i = 0; i < 8; ++i) o[i] = (f16)(tile[(k8 + i) * 65 + n] * sc);
    *(f16x8*)(dst + (size_t)(drow0 + n) * ldd + k0 + k8) = o;
  }
  __syncthreads();
}

__device__ __forceinline__ void phase_weights(const Args& a, float* tile, int swid) {
  constexpr int T_IN = 16 * 112, T_SQ = 16 * 16, T_UP = 16 * 88, T_DN = 44 * 16, T_PL = 4 * 16;
  constexpr int T_LAYER = T_IN + 3 * T_SQ + T_UP + T_DN + T_PL;
  unsigned char* ws = a.ws;
  for (int idx = blockIdx.x; idx < 2 * T_LAYER; idx += gridDim.x) {
    const int l = idx / T_LAYER; int j = idx % T_LAYER;
    if (j < T_IN) { const int kt = j / 112, nt = j % 112;
      tp_tile(a.w_in + (size_t)l * DM * INW, INW, kt * 64, nt * 64, (f16*)(ws + WS_WIN) + (size_t)l * INW * DM, DM, nt * 64, nullptr, tile, swid); continue; }
    j -= T_IN;
    if (j < 3 * T_SQ) { const int w = j / T_SQ, jj = j % T_SQ, kt = jj / 16, nt = jj % 16;
      const float* src = (w == 0 ? a.w_a : (w == 1 ? a.w_b : a.w_out)) + (size_t)l * DM * DM;
      f16* dst = (f16*)(ws + (w == 0 ? WS_WA : (w == 1 ? WS_WB : WS_WO))) + (size_t)l * DM * DM;
      tp_tile(src, DM, kt * 64, nt * 64, dst, DM, nt * 64, nullptr, tile, swid); continue; }
    j -= 3 * T_SQ;
    if (j < T_UP) { const int kt = j / 88, nt = j % 88; const int n0 = nt * 64, bj = n0 / DFF, rem = n0 % DFF, p = rem / 128, j0 = rem % 128;
      tp_tile(a.w_up + (size_t)l * DM * NUP, NUP, kt * 64, n0, (f16*)(ws + WS_WUP) + (size_t)l * NUP * DM, DM, p * 256 + bj * 128 + j0, nullptr, tile, swid); continue; }
    j -= T_UP;
    if (j < T_DN) { const int kt = j / 16, nt = j % 16;
      tp_tile(a.w_down + (size_t)l * DFF * DM, DM, kt * 64, nt * 64, (f16*)(ws + WS_WDN) + (size_t)l * DM * DFF, DFF, nt * 64, nullptr, tile, swid); continue; }
    j -= T_DN;
    { const int g = j / 16, jj = j % 16, kt = jj / 4, nt = jj % 4;
      tp_tile(a.pool_w + ((size_t)l * 4 + g) * 256 * 256, 256, kt * 64, nt * 64, (f16*)(ws + WS_WP) + ((size_t)l * 4 + g) * 256 * 256, 256, nt * 64,
              a.pool_scale + (size_t)l * DM + g * 256, tile, swid); }
  }
}

__device__ __forceinline__ int row_kind(const Round& R, int row, int& s, int& o) {
  if (row < 64) { s = row >> 4; o = row & 15; return s < R.nseq ? 1 : 0; }
  if (row < RB) return 0;
  const int q = row - RB; s = q / R.S; o = q - s * R.S; return 2;
}
__device__ __forceinline__ const float* x_row(const Args& a, const Round& R, int s, int i) {
  return R.is_sample ? a.x_sample + ((size_t)R.b0 * 16384 + i) * DM : a.x_prompt + ((size_t)(R.b0 + s) * 4096 + i) * DM;
}
__device__ __forceinline__ float* out_row(const Args& a, const Round& R, int s, int i) {
  return R.is_sample ? a.out + (size_t)8 * 4096 * DM + ((size_t)R.b0 * 16384 + i) * DM : a.out + ((size_t)(R.b0 + s) * 4096 + i) * DM;
}
__device__ __forceinline__ void store_h(const Args& a, int row, int lane, const f32x4 (&v)[4]) {
  float* h32 = (float*)(a.ws + WS_H32) + (size_t)row * DM; f16* h16 = (f16*)(a.ws + WS_H16) + (size_t)row * DM;
#pragma unroll
  for (int i = 0; i < 4; ++i) { const int c = i * 256 + lane * 4;
    *(f32x4*)(h32 + c) = v[i];
    f16x4 h = {(f16)v[i][0], (f16)v[i][1], (f16)v[i][2], (f16)v[i][3]}; *(f16x4*)(h16 + c) = h; }
}
__device__ __forceinline__ void init_row(const Args& a, const Round& R, int row, int lane) {
  int s = 0, o = 0; const int kd = row_kind(R, row, s, o);
  f32x4 v[4];
  const float* src = kd == 1 ? a.meta + (size_t)o * DM : (kd == 2 ? x_row(a, R, s, o) : nullptr);
#pragma unroll
  for (int i = 0; i < 4; ++i) v[i] = src ? *(const f32x4*)(src + i * 256 + lane * 4) : (f32x4){0.f, 0.f, 0.f, 0.f};
  store_h(a, row, lane, v);
}
__device__ __forceinline__ void ln_row(const Args& a, const Round& R, int row, int lane, const float* __restrict__ g, const float* __restrict__ b, int to_out, int dry) {
  const float* h32 = (const float*)(a.ws + WS_H32) + (size_t)row * DM;
  f32x4 v[4]; float s = 0.f;
#pragma unroll
  for (int i = 0; i < 4; ++i) { v[i] = *(const f32x4*)(h32 + i * 256 + lane * 4); s += (v[i][0] + v[i][1]) + (v[i][2] + v[i][3]); }
#pragma unroll
  for (int o = 32; o >= 1; o >>= 1) s += __shfl_xor(s, o);
  const float mu = s * (1.0f / DM); float q = 0.f;
#pragma unroll
  for (int i = 0; i < 4; ++i) { const f32x4 d = v[i] - mu; q += (d[0] * d[0] + d[1] * d[1]) + (d[2] * d[2] + d[3] * d[3]); }
#pragma unroll
  for (int o = 32; o >= 1; o >>= 1) q += __shfl_xor(q, o);
  const float rstd = 1.0f / sqrtf(q * (1.0f / DM) + 1e-5f);
#pragma unroll
  for (int i = 0; i < 4; ++i) { const f32x4 gg = *(const f32x4*)(g + i * 256 + lane * 4), bb = *(const f32x4*)(b + i * 256 + lane * 4); v[i] = (v[i] - mu) * rstd * gg + bb; }
  if (dry) return;
  if (!to_out) { store_h(a, row, lane, v); return; }
  int sq = 0, o = 0; const int kd = row_kind(R, row, sq, o);
  if (kd == 2) { float* dst = out_row(a, R, sq, o);
#pragma unroll
    for (int i = 0; i < 4; ++i) *(f32x4*)(dst + i * 256 + lane * 4) = v[i]; }
}
__device__ __forceinline__ void phase_rows(const Args& a, const Round& R, int mode, const float* g, const float* b, int rn, int swid, int dry = 0) {
  const int tid_ = opaque_tid(swid); const int wid = tid_ >> 6, lane = tid_ & 63;
  const int nw = gridDim.x * 8;
  if (mode != 0) for (int v = blockIdx.x * 8 + wid; v < MROWS - 64; v += nw) ln_row(a, R, v < 64 ? v : v + 64, lane, g, b, mode == 2, dry);
  if (mode == 1 || rn < 0 || dry) return;
  const Round Rn = get_round(rn);
  for (int v = blockIdx.x * 8 + wid; v < MROWS - 64; v += nw) init_row(a, Rn, v < 64 ? v : v + 64, lane);
}

constexpr int BM = 256, BK = 64, HALF = 128, HTB = HALF * BK * 2, NXCD = 8, WGM = 8;
__device__ __forceinline__ int lds_byte(int r, int c) { const int st = (r >> 4) * 2 + (c >> 5), rr = r & 15, cc = c & 31, ob = rr * 64 + cc * 2; return st * 1024 + (ob ^ (((ob >> 9) & 1) << 5)); }
__device__ __forceinline__ void stage_rc(int b, int& R, int& C) { const int st = b / 1024, sb = b % 1024, swz = sb ^ (((sb >> 9) & 1) << 5); R = (st >> 1) * 16 + swz / 64; C = (st & 1) * 32 + (swz % 64) / 2; }

struct GUnit { const char* A; const char* B; int pm, pn; };

__device__ __forceinline__ void tile_map(int L, int nM, int nN, int& pm, int& pn) {
  const int nwg = nM * nN; int wgid = L;
  { const int q = nwg / NXCD, r = nwg % NXCD, xcd = wgid % NXCD, off = wgid / NXCD; wgid = (xcd < r ? xcd * (q + 1) : r * (q + 1) + (xcd - r) * q) + off; }
  const int nig = WGM * nN, gid = wgid / nig, fm = gid * WGM, gsz = (nM - fm) < WGM ? (nM - fm) : WGM;
  pm = fm + ((wgid % nig) % gsz); pn = (wgid % nig) / gsz;
}

template <int LDA2, int LDB2, int NT, class Sched, class Epi>
__device__ __forceinline__ void gemm_phase(LAS unsigned char* lds, const Sched& S, const Epi& E, int swid) {
  const int tid = opaque_tid(swid), wid = __builtin_amdgcn_readfirstlane(tid >> 6), lane = tid & 63, wr = wid >> 2, wc = wid & 3, fr = lane & 15, fq = lane >> 4;
  unsigned voffA[2], voffB[2];
#pragma unroll
  for (int i = 0; i < 2; ++i) { int R, C; stage_rc(tid * 16 + i * 8192, R, C); voffA[i] = (unsigned)(R * LDA2 + C * 2); voffB[i] = (unsigned)(R * LDB2 + C * 2); }
  constexpr size_t kstep = (size_t)(BK * 2);
  constexpr size_t hA = (size_t)HALF * LDA2, hB = (size_t)HALF * LDB2;
  const unsigned ldsw = (unsigned)wid * 1024u;
  const int aoff = lds_byte(wr * 64 + fr, fq * 8), boff = lds_byte(wc * 32 + fr, fq * 8);
#define G_SA(b, h) (((b) * 2 + (h)) * HTB)
#define G_SB(b, h) ((4 + (b) * 2 + (h)) * HTB)
#define G_STAGE(bufoff, gbase, voff) do { _Pragma("unroll") for (int _i = 0; _i < 2; ++_i) \
    __builtin_amdgcn_global_load_lds((const unsigned*)((const char*)(gbase) + (voff)[_i]), (LAS unsigned*)(lds + (bufoff) + ldsw + _i * 8192), 16, 0, 0); } while (0)
#define G_LDA(dst, b, h) do { _Pragma("unroll") for (int m = 0; m < 4; ++m) _Pragma("unroll") for (int k = 0; k < 2; ++k) dst[m][k] = *(const LAS f16x8*)(lds + G_SA(b, h) + aoff + m * 2048 + k * 1024); } while (0)
#define G_LDB(dst, b, h) do { _Pragma("unroll") for (int n = 0; n < 2; ++n) _Pragma("unroll") for (int k = 0; k < 2; ++k) dst[n][k] = *(const LAS f16x8*)(lds + G_SB(b, h) + boff + n * 2048 + k * 1024); } while (0)
#define G_MMA(ai, bj, At, Bt) do { __builtin_amdgcn_s_setprio(1); _Pragma("unroll") for (int m = 0; m < 4; ++m) _Pragma("unroll") for (int n = 0; n < 2; ++n) _Pragma("unroll") for (int k = 0; k < 2; ++k) \
    acc[ai][bj][m][n] = __builtin_amdgcn_mfma_f32_16x16x32_f16(Bt[n][k], At[m][k], acc[ai][bj][m][n], 0, 0, 0); __builtin_amdgcn_s_setprio(0); } while (0)
#define G_WAIT_V(n) asm volatile("s_waitcnt vmcnt(" #n ")" ::: "memory")
#define G_WAIT_L(n) asm volatile("s_waitcnt lgkmcnt(" #n ")" ::: "memory")
#define G_BAR __builtin_amdgcn_s_barrier()
#define G_SCHED __builtin_amdgcn_sched_barrier(0)
  GUnit cur, nxt; int ui = 0;
  if (!S.next(0, cur)) return;
  f32x4 acc[2][2][4][2];
#pragma unroll
  for (int a = 0; a < 2; ++a)
#pragma unroll
    for (int b = 0; b < 2; ++b)
#pragma unroll
      for (int m = 0; m < 4; ++m)
#pragma unroll
        for (int n = 0; n < 2; ++n) acc[a][b][m][n] = (f32x4){0.f, 0.f, 0.f, 0.f};
  f16x8 At[4][2], B0[2][2], B1[2][2];
  const char* cA = cur.A; const char* cB = cur.B;
  G_STAGE(G_SB(0, 0), cB, voffB); G_STAGE(G_SA(0, 0), cA, voffA); G_STAGE(G_SB(0, 1), cB + hB, voffB); G_STAGE(G_SA(0, 1), cA + hA, voffA);
  if (wr == 1) G_BAR;
  G_WAIT_V(4); G_BAR;
  G_STAGE(G_SB(1, 0), cB + kstep, voffB); G_STAGE(G_SA(1, 0), cA + kstep, voffA); G_STAGE(G_SB(1, 1), cB + hB + kstep, voffB);
  G_WAIT_V(6); G_BAR;
  for (;;) {
    const bool has_next = S.next(ui + 1, nxt);
    const char* nA = has_next ? nxt.A : cA; const char* nB = has_next ? nxt.B : cB;
#pragma unroll 1
    for (int t = 0; t < NT; t += 2) {
      const bool last = (t == NT - 2);
      const char* a1 = cA + (size_t)(t + 1) * kstep;
      const char* a2 = last ? nA : cA + (size_t)(t + 2) * kstep; const char* b2 = last ? nB : cB + (size_t)(t + 2) * kstep;
      const char* a3 = a2 + kstep; const char* b3 = b2 + kstep;
      G_LDB(B0, 0, 0); G_SCHED; G_LDA(At, 0, 0); G_STAGE(G_SA(1, 1), a1 + hA, voffA);
      G_WAIT_L(8); G_BAR; G_WAIT_L(0); G_MMA(0, 0, At, B0); G_BAR; G_SCHED;
      G_LDB(B1, 0, 1); G_STAGE(G_SB(0, 0), b2, voffB);
      G_BAR; G_WAIT_L(0); G_MMA(0, 1, At, B1); G_BAR;
      G_LDA(At, 0, 1); G_STAGE(G_SA(0, 0), a2, voffA);
      G_BAR; G_WAIT_L(0); G_MMA(1, 0, At, B0); G_BAR; G_SCHED;
      G_STAGE(G_SB(0, 1), b2 + hB, voffB);
      G_WAIT_V(6); G_BAR; G_MMA(1, 1, At, B1); G_BAR;
      G_LDB(B0, 1, 0); G_SCHED; G_LDA(At, 1, 0); G_STAGE(G_SA(0, 1), a2 + hA, voffA);
      G_WAIT_L(8); G_BAR; G_WAIT_L(0); G_MMA(0, 0, At, B0); G_BAR; G_SCHED;
      G_LDB(B1, 1, 1); G_STAGE(G_SB(1, 0), b3, voffB);
      G_BAR; G_WAIT_L(0); G_MMA(0, 1, At, B1); G_BAR;
      G_LDA(At, 1, 1); G_STAGE(G_SA(1, 0), a3, voffA);
      G_BAR; G_WAIT_L(0); G_MMA(1, 0, At, B0); G_BAR; G_SCHED;
      G_STAGE(G_SB(1, 1), b3 + hB, voffB);
      G_WAIT_V(6); G_BAR; G_MMA(1, 1, At, B1); G_BAR;
    }
    E(acc, cur, wr, wc, fr, fq);
    if (!has_next) break;
#pragma unroll
    for (int a = 0; a < 2; ++a)
#pragma unroll
      for (int b = 0; b < 2; ++b)
#pragma unroll
        for (int m = 0; m < 4; ++m)
#pragma unroll
          for (int n = 0; n < 2; ++n) acc[a][b][m][n] = (f32x4){0.f, 0.f, 0.f, 0.f};
    cur = nxt; cA = nA; cB = nB; ++ui;
  }
  G_WAIT_V(0);
  if (wr == 0) G_BAR;
  G_BAR;
#undef G_SA
#undef G_SB
#undef G_STAGE
#undef G_LDA
#undef G_LDB
#undef G_MMA
#undef G_WAIT_V
#undef G_WAIT_L
#undef G_BAR
#undef G_SCHED
}

template <int PH> struct Sched {
  const unsigned char* ws; int l, nM, G, c;
  __device__ __forceinline__ bool next(int i, GUnit& u) const {
    constexpr int nN = PH == 1 ? 28 : (PH == 7 ? 22 : 4);
    const long L = (long)i * G + c; if (L >= (long)nM * nN) return false;
    int pm, pn; tile_map((int)L, nM, nN, pm, pn);
    u.pm = pm; u.pn = pn;
    if (PH == 1)  { u.A = (const char*)(ws + WS_H16) + (size_t)(RB + pm * 256) * DM * 2; u.B = (const char*)(ws + WS_WIN) + ((size_t)l * INW + (size_t)pn * 256) * DM * 2; }
    if (PH == 40) { u.A = (const char*)(ws + WS_U) + ((size_t)(RB + pm * 256) * INW + C_QA) * 2; u.B = (const char*)(ws + WS_WA) + ((size_t)l * DM + (size_t)pn * 256) * DM * 2; }
    if (PH == 41) { u.A = (const char*)(ws + WS_U) + ((size_t)(RB + pm * 256) * INW + C_QB) * 2; u.B = (const char*)(ws + WS_WB) + ((size_t)l * DM + (size_t)pn * 256) * DM * 2; }
    if (PH == 42) { u.A = (const char*)(ws + WS_PD) + ((size_t)(RB + pm * 256) * DM + pn * 256) * 2; u.B = (const char*)(ws + WS_WP) + ((size_t)l * 4 + pn) * 256 * 256 * 2; }
    if (PH == 5)  { u.A = (const char*)(ws + WS_MG) + (size_t)(RB + pm * 256) * DM * 2; u.B = (const char*)(ws + WS_WO) + ((size_t)l * DM + (size_t)pn * 256) * DM * 2; }
    if (PH == 7)  { u.A = (const char*)(ws + WS_H16) + (size_t)(RB + pm * 256) * DM * 2; u.B = (const char*)(ws + WS_WUP) + ((size_t)l * NUP + (size_t)pn * 256) * DM * 2; }
    if (PH == 8)  { u.A = (const char*)(ws + WS_U) + (size_t)(RB + pm * 256) * DFF * 2; u.B = (const char*)(ws + WS_WDN) + ((size_t)l * DM + (size_t)pn * 256) * DFF * 2; }
    return true;
  }
};

__device__ __forceinline__ f16x4 to_h4(f32x4 v) { f16x4 h = {(f16)v[0], (f16)v[1], (f16)v[2], (f16)v[3]}; return h; }
__device__ __forceinline__ f32x4 to_f4(f16x4 h) { f32x4 v = {(float)h[0], (float)h[1], (float)h[2], (float)h[3]}; return v; }
struct EpiU { int dry;
  unsigned char* ws;
  __device__ __forceinline__ void operator()(const f32x4 (&acc)[2][2][4][2], const GUnit& u, int wr, int wc, int fr, int fq) const {
    if (dry) return;
    f16* U = (f16*)(ws + WS_U);
    const int row0 = RB + u.pm * BM + wr * 64 + fr, col0 = u.pn * BM + wc * 32 + 4 * fq;
#pragma unroll
    for (int ai = 0; ai < 2; ++ai)
#pragma unroll
      for (int m = 0; m < 4; ++m) { f16* rowp = U + (size_t)(row0 + ai * HALF + m * 16) * INW + col0;
#pragma unroll
        for (int bj = 0; bj < 2; ++bj)
#pragma unroll
          for (int n = 0; n < 2; ++n) *(f16x4*)(rowp + bj * HALF + n * 16) = to_h4(acc[ai][bj][m][n]); }
  }
};
template <int KIND> struct EpiGate { int dry;
  unsigned char* ws;
  __device__ __forceinline__ void operator()(const f32x4 (&acc)[2][2][4][2], const GUnit& u, int wr, int wc, int fr, int fq) const {
    if (dry) return;
    const f16* U = (const f16*)(ws + WS_U); f16* MG = (f16*)(ws + WS_MG);
    const int row0 = RB + u.pm * BM + wr * 64 + fr, col0 = u.pn * BM + wc * 32 + 4 * fq;
    constexpr int kind = KIND;
#pragma unroll
    for (int ai = 0; ai < 2; ++ai)
#pragma unroll
      for (int m = 0; m < 4; ++m) { const size_t row = (size_t)(row0 + ai * HALF + m * 16);
        const f16* gp = U + row * INW + C_UG + kind * DM + col0; f16* mp = MG + row * DM + col0;
#pragma unroll
        for (int bj = 0; bj < 2; ++bj)
#pragma unroll
          for (int n = 0; n < 2; ++n) { const f32x4 g = to_f4(*(const f16x4*)(gp + bj * HALF + n * 16)); f32x4 v = acc[ai][bj][m][n];
#pragma unroll
            for (int j = 0; j < 4; ++j) v[j] = v[j] / (1.0f + __expf(-g[j]));
            if (kind != 0) v += to_f4(*(const f16x4*)(mp + bj * HALF + n * 16));
            *(f16x4*)(mp + bj * HALF + n * 16) = to_h4(v); } }
  }
};
struct EpiResid { int dry;
  unsigned char* ws;
  __device__ __forceinline__ void operator()(const f32x4 (&acc)[2][2][4][2], const GUnit& u, int wr, int wc, int fr, int fq) const {
    if (dry) return;
    float* H = (float*)(ws + WS_H32);
    const int row0 = RB + u.pm * BM + wr * 64 + fr, col0 = u.pn * BM + wc * 32 + 4 * fq;
#pragma unroll
    for (int ai = 0; ai < 2; ++ai)
#pragma unroll
      for (int m = 0; m < 4; ++m) { float* rowp = H + (size_t)(row0 + ai * HALF + m * 16) * DM + col0;
#pragma unroll
        for (int bj = 0; bj < 2; ++bj)
#pragma unroll
          for (int n = 0; n < 2; ++n) { const f32x4 o = *(const f32x4*)(rowp + bj * HALF + n * 16); *(f32x4*)(rowp + bj * HALF + n * 16) = o * ALPHA + acc[ai][bj][m][n]; } }
  }
};
struct EpiSwiglu { int dry;
  unsigned char* ws;
  __device__ __forceinline__ void operator()(const f32x4 (&acc)[2][2][4][2], const GUnit& u, int wr, int wc, int fr, int fq) const {
    if (dry) return;
    f16* HID = (f16*)(ws + WS_U);
    const int row0 = RB + u.pm * BM + wr * 64 + fr, col0 = u.pn * HALF + wc * 32 + 4 * fq;
#pragma unroll
    for (int ai = 0; ai < 2; ++ai)
#pragma unroll
      for (int m = 0; m < 4; ++m) { f16* rowp = HID + (size_t)(row0 + ai * HALF + m * 16) * DFF + col0;
#pragma unroll
        for (int n = 0; n < 2; ++n) { const f32x4 g = acc[ai][0][m][n], up = acc[ai][1][m][n]; f32x4 v;
#pragma unroll
          for (int j = 0; j < 4; ++j) v[j] = g[j] / (1.0f + __expf(-g[j])) * up[j];
          *(f16x4*)(rowp + n * 16) = to_h4(v); } }
  }
};

__device__ __forceinline__ void slab_partial(const f16* __restrict__ A, int lda, const f16* __restrict__ B, int ldb, int kbeg, int kend, int fr, int fq, f32x4 (&acc)[4]) {
  for (int k = kbeg; k < kend; k += 32) {
    const f16x8 w = *(const f16x8*)(B + (size_t)fr * ldb + k + fq * 8);
#pragma unroll
    for (int mb = 0; mb < 4; ++mb) { const f16x8 av = *(const f16x8*)(A + (size_t)(mb * 16 + fr) * lda + k + fq * 8);
      acc[mb] = __builtin_amdgcn_mfma_f32_16x16x32_f16(w, av, acc[mb], 0, 0, 0); }
  }
}
__device__ __forceinline__ void slab_reduce(const f32x4 (&acc)[4], float* red, int tid, float& v0, float& v1) {
  const int wid = tid >> 6, lane = tid & 63;
  __syncthreads();
#pragma unroll
  for (int mb = 0; mb < 4; ++mb) *(f32x4*)(red + ((wid * 4 + mb) * 64 + lane) * 4) = acc[mb];
  __syncthreads();
  float v[2];
#pragma unroll
  for (int i = 0; i < 2; ++i) { const int e = tid + 512 * i, row = e >> 4, col = e & 15, mb = row >> 4, fr = row & 15, fq = col >> 2, j = col & 3; float s = 0.f;
#pragma unroll
    for (int w = 0; w < 8; ++w) s += red[((w * 4 + mb) * 64 + fq * 16 + fr) * 4 + j];
    v[i] = s; }
  v0 = v[0]; v1 = v[1];
}
__device__ __forceinline__ void slab_full(const f16* A, int lda, const f16* B, int ldb, int K, float* red, int tid, float& v0, float& v1) {
  const int wid = tid >> 6, lane = tid & 63, fr = lane & 15, fq = lane >> 4;
  f32x4 acc[4];
#pragma unroll
  for (int mb = 0; mb < 4; ++mb) acc[mb] = (f32x4){0.f, 0.f, 0.f, 0.f};
  const int ks = K >> 3;
  slab_partial(A, lda, B, ldb, wid * ks, wid * ks + ks, fr, fq, acc);
  slab_reduce(acc, red, tid, v0, v1);
}
template <int PH>
__device__ __forceinline__ void meta_gemm(const Args& a, int l, float* red, int swid) {
  const int tid = opaque_tid(swid);
  unsigned char* ws = a.ws;
  f16* U = (f16*)(ws + WS_U); f16* MG = (f16*)(ws + WS_MG); float* H32 = (float*)(ws + WS_H32); const f16* H16 = (const f16*)(ws + WS_H16); const f16* PD = (const f16*)(ws + WS_PD);
  constexpr int NSLAB = PH == 1 ? INW / 16 : (PH == 7 ? DFF / 16 : DM / 16);
  for (int sl = blockIdx.x; sl < NSLAB; sl += gridDim.x) {
    const int n0 = sl * 16;
    float v[2], w[2], x[2];
    if (PH == 1) slab_full(H16, DM, (const f16*)(ws + WS_WIN) + ((size_t)l * INW + n0) * DM, DM, DM, red, tid, v[0], v[1]);
    if (PH == 4) {
      slab_full(U + C_QA, INW, (const f16*)(ws + WS_WA) + ((size_t)l * DM + n0) * DM, DM, DM, red, tid, v[0], v[1]);
      slab_full(U + C_QB, INW, (const f16*)(ws + WS_WB) + ((size_t)l * DM + n0) * DM, DM, DM, red, tid, w[0], w[1]);
      const int g = n0 >> 8;
      slab_full(PD + g * 256, DM, (const f16*)(ws + WS_WP) + ((size_t)l * 4 + g) * 256 * 256 + (size_t)(n0 & 255) * 256, 256, 256, red, tid, x[0], x[1]);
    }
    if (PH == 5) slab_full(MG, DM, (const f16*)(ws + WS_WO) + ((size_t)l * DM + n0) * DM, DM, DM, red, tid, v[0], v[1]);
    if (PH == 7) { const int p = n0 >> 7, j0 = n0 & 127;
      const f16* Bg = (const f16*)(ws + WS_WUP) + ((size_t)l * NUP + p * 256 + j0) * DM;
      slab_full(H16, DM, Bg, DM, DM, red, tid, v[0], v[1]);
      slab_full(H16, DM, Bg + (size_t)128 * DM, DM, DM, red, tid, w[0], w[1]); }
    if (PH == 8) slab_full(U, DFF, (const f16*)(ws + WS_WDN) + ((size_t)l * DM + n0) * DFF, DFF, DFF, red, tid, v[0], v[1]);
#pragma unroll
    for (int i = 0; i < 2; ++i) { const int e = tid + 512 * i, row = e >> 4, col = n0 + (e & 15);
      if (PH == 1) U[(size_t)row * INW + col] = (f16)v[i];
      if (PH == 4) { const f16* gp = U + (size_t)row * INW + C_UG + col;
        const float g0 = (float)gp[0], g1 = (float)gp[DM], g2 = (float)gp[2 * DM];
        MG[(size_t)row * DM + col] = (f16)(v[i] / (1.0f + __expf(-g0)) + w[i] / (1.0f + __expf(-g1)) + x[i] / (1.0f + __expf(-g2))); }
      if (PH == 5 || PH == 8) { float* hp = H32 + (size_t)row * DM + col; *hp = *hp * ALPHA + v[i]; }
      if (PH == 7) ((f16*)(ws + WS_U))[(size_t)row * DFF + col] = (f16)(v[i] / (1.0f + __expf(-v[i])) * w[i]); }
  }
  __syncthreads();
}

__device__ __forceinline__ float wave_sum(float s) {
#pragma unroll
  for (int o = 32; o >= 1; o >>= 1) s += __shfl_xor(s, o);
  return s;
}
__device__ __forceinline__ void sincos_turns(float ang, float& sn, float& cs) {
  const double t = (double)ang * 0.15915494309189533577;
  const float fr = (float)(t - floor(t));
  sn = __builtin_amdgcn_sinf(fr); cs = __builtin_amdgcn_cosf(fr);
}
__device__ __forceinline__ void phase_prep(const Args& a, const Round& R, int l, int dry, int swid) {
  const int tid_ = opaque_tid(swid); const int wid = tid_ >> 6, lane = tid_ & 63;
  f16* U = (f16*)(a.ws + WS_U); f16* PD = (f16*)(a.ws + WS_PD);
  const int L = R.S + 16, ntok = R.nseq * L;
  const int iA = lane & 31, secA = lane >> 5;
  const int dA1 = secA * 64 + iA, dA2 = dA1 + 32;
  const int dB1 = lane, dB2 = lane + 64;
  const float invA = (float)exp2(-(double)(2 * iA) / 64.0 * 13.287712379549449);
  const float invB = (float)exp2(-(double)(2 * lane) / 128.0 * 13.287712379549449);
  const float gq1 = a.qg[l * 128 + dA1], gq2 = a.qg[l * 128 + dA2], gk1 = a.kg[l * 128 + dA1], gk2 = a.kg[l * 128 + dA2];
  const int pg = lane >> 4, win = 2 << pg, c0 = lane * 16;
  for (int tok = blockIdx.x * 8 + wid; tok < ntok; tok += gridDim.x * 8) {
    const int s = tok / L, t = tok - s * L;
    const int mb_ = 16 * s, rb_ = RB + R.S * s - 16;
    const int row = t < 16 ? mb_ + t : rb_ + t;
    f16* up = U + (size_t)row * INW;
    int prow, pcol;
    if (t < 16) { prow = -1; pcol = t; } else { const int i = t - 16; prow = i >> 6; pcol = i & 63; }
    float snA, csA, snB, csB;
    sincos_turns((float)(secA ? pcol : prow) * invA, snA, csA);
    sincos_turns((float)t * invB, snB, csB);
#pragma unroll
    for (int h = 0; h < 10; ++h) {
      f16* p = up + (h < 8 ? C_QA + h * 128 : C_KA + (h - 8) * 128);
      float x1 = (float)p[dA1], x2 = (float)p[dA2];
      const float ss = wave_sum(x1 * x1 + x2 * x2);
      const float rs = 1.0f / sqrtf(ss * (1.0f / 128.0f) + 1e-6f);
      x1 = x1 * rs * (h < 8 ? gq1 : gk1); x2 = x2 * rs * (h < 8 ? gq2 : gk2);
      if (!dry) { p[dA1] = (f16)(x1 * csA - x2 * snA); p[dA2] = (f16)(x1 * snA + x2 * csA); }
    }
#pragma unroll
    for (int h = 0; h < 10; ++h) {
      f16* p = up + (h < 8 ? C_QB + h * 128 : C_KB + (h - 8) * 128);
      const float x1 = (float)p[dB1], x2 = (float)p[dB2];
      if (!dry) { p[dB1] = (f16)(x1 * csB - x2 * snB); p[dB2] = (f16)(x1 * snB + x2 * csB); }
    }
    {
      int lo = t - win / 2; int hi = lo + win; lo = lo < 0 ? 0 : lo; hi = hi > L ? L : hi;
      float acc[16];
#pragma unroll
      for (int j = 0; j < 16; ++j) acc[j] = 0.f;
      for (int tt = lo; tt < hi; ++tt) {
        const f16* q = U + (size_t)(tt < 16 ? mb_ + tt : rb_ + tt) * INW + C_UC + c0;
        const f16x8 v0 = *(const f16x8*)q, v1 = *(const f16x8*)(q + 8);
#pragma unroll
        for (int j = 0; j < 8; ++j) { acc[j] += (float)v0[j]; acc[8 + j] += (float)v1[j]; }
      }
      const float rc = 1.0f / (float)(hi - lo);
      const f16x8 s0 = *(const f16x8*)(up + C_UC + c0), s1 = *(const f16x8*)(up + C_UC + c0 + 8);
      f16x8 o0, o1;
#pragma unroll
      for (int j = 0; j < 8; ++j) { o0[j] = (f16)(acc[j] * rc - (float)s0[j]); o1[j] = (f16)(acc[8 + j] * rc - (float)s1[j]); }
      if (!dry) { *(f16x8*)(PD + (size_t)row * DM + c0) = o0; *(f16x8*)(PD + (size_t)row * DM + c0 + 8) = o1; }
    }
  }
}

constexpr int AD = 128, KVBLK = 64, LDQ = INW;
constexpr float ASCALE = 0.088388347648318440f;
constexpr float ATHR = 8.f;
constexpr int SHM_V = KVBLK * AD * 2, SHM_K = KVBLK * AD * 2;
typedef short s16x4 __attribute__((ext_vector_type(4)));
#define KSWZ(row, colB) ((row) * 256 + ((colB) ^ (((row) & 7) << 4)))
#define SBAR() __builtin_amdgcn_sched_barrier(0)
__device__ __forceinline__ int crow(int r, int hi) { return (r & 3) + 8 * (r >> 2) + 4 * hi; }
__device__ __forceinline__ unsigned cvtpk(float lo, float hi) { f16x2 v = {(f16)lo, (f16)hi}; return __builtin_bit_cast(unsigned, v); }

__device__ __forceinline__ void partialSM(f32x16& p0, f32x16& p1, float& m_reg, float& mn, float& alpha) {
  constexpr float C = ASCALE * 1.4426950408889634f;
  float pmax = p0[0];
#pragma unroll
  for (int r = 1; r < 16; ++r) pmax = fmaxf(pmax, p0[r]);
#pragma unroll
  for (int r = 0; r < 16; ++r) pmax = fmaxf(pmax, p1[r]);
  { auto rr = __builtin_amdgcn_permlane32_swap(__float_as_uint(pmax), __float_as_uint(pmax), false, false);
    pmax = fmaxf(__uint_as_float(rr[0]), __uint_as_float(rr[1])); }
  if (__builtin_expect(__all(pmax - m_reg <= ATHR / ASCALE), 1)) { mn = m_reg; alpha = 1.f; }
  else { mn = fmaxf(m_reg, pmax); alpha = __builtin_amdgcn_exp2f((m_reg - mn) * C); m_reg = mn; }
  const float mnC = -mn * C;
#pragma unroll
  for (int r = 0; r < 16; ++r) p0[r] = fmaf(p0[r], C, mnC);
#pragma unroll
  for (int r = 0; r < 16; ++r) p1[r] = fmaf(p1[r], C, mnC);
#pragma unroll
  for (int r = 0; r < 16; ++r) p0[r] = __builtin_amdgcn_exp2f(p0[r]);
}
__device__ __forceinline__ void finishSM(f32x16& p0, f32x16& p1, float alpha, float& l_reg, f16x8& pa0, f16x8& pa1, f16x8& pa2, f16x8& pa3) {
#pragma unroll
  for (int r = 0; r < 16; ++r) p1[r] = __builtin_amdgcn_exp2f(p1[r]);
  float ps = 0;
#pragma unroll
  for (int r = 0; r < 16; ++r) ps += p0[r];
#pragma unroll
  for (int r = 0; r < 16; ++r) ps += p1[r];
  { auto rr = __builtin_amdgcn_permlane32_swap(__float_as_uint(ps), __float_as_uint(ps), false, false);
    ps = __uint_as_float(rr[0]) + __uint_as_float(rr[1]); }
  l_reg = l_reg * alpha + ps;
#define PK4(P, BASE, OUT) do { unsigned a0 = cvtpk(P[BASE + 0], P[BASE + 1]), a1 = cvtpk(P[BASE + 2], P[BASE + 3]);   \
    unsigned b0 = cvtpk(P[BASE + 4], P[BASE + 5]), b1 = cvtpk(P[BASE + 6], P[BASE + 7]);                              \
    auto r0 = __builtin_amdgcn_permlane32_swap(a0, b0, false, false); auto r1 = __builtin_amdgcn_permlane32_swap(a1, b1, false, false); \
    u32x4 w = {r0[0], r1[0], r0[1], r1[1]}; OUT = __builtin_bit_cast(f16x8, w); } while (0)
  PK4(p0, 0, pa0); PK4(p0, 8, pa1); PK4(p1, 0, pa2); PK4(p1, 8, pa3);
#undef PK4
}
__device__ __forceinline__ void qkt(f32x16& p0, f32x16& p1, const char* Ks, const f16x8* qr, int r32, int hi) {
  p0 = f32x16{}; p1 = f32x16{};
#pragma unroll
  for (int d0 = 0; d0 < 8; ++d0) { const int cb = (d0 * 16 + hi * 8) * 2;
    const f16x8 b0 = *reinterpret_cast<const f16x8*>(Ks + KSWZ(r32, cb));
    const f16x8 b1 = *reinterpret_cast<const f16x8*>(Ks + KSWZ(32 + r32, cb));
    p0 = __builtin_amdgcn_mfma_f32_32x32x16_f16(b0, qr[d0], p0, 0, 0, 0);
    p1 = __builtin_amdgcn_mfma_f32_32x32x16_f16(b1, qr[d0], p1, 0, 0, 0); }
}
__device__ __forceinline__ void mask_tile(f32x16& p0, f32x16& p1, int ka, int kb, int hi) {
  const int a2 = ka - 4 * hi; const unsigned span = (unsigned)(kb - ka);
#pragma unroll
  for (int r = 0; r < 16; ++r) { const int c = (r & 3) + 8 * (r >> 2);
    p0[r] = ((unsigned)(c - a2) <= span && kb >= ka) ? p0[r] : -1e30f;
    p1[r] = ((unsigned)(c + 32 - a2) <= span && kb >= ka) ? p1[r] : -1e30f; }
}
__device__ __forceinline__ int v_st(int k, int c) { const int kk = (k & ~0xC) | ((k & 4) << 1) | ((k & 8) >> 1); return ((kk >> 3) * 4 + (c >> 5)) * 512 + ((kk & 7) * 32 + (c & 31)) * 2; }
__device__ __forceinline__ int v_rd_base(int lane) { return ((lane & 3) << 3) | (((lane >> 2) & 3) << 6) | (((lane >> 4) & 1) << 5) | (((lane >> 5) & 1) << 8); }
constexpr int v_rd_off(int d0, int ks, int half) { return d0 * 512 + ks * 4096 + half * 2048; }
template <int OFF> __device__ __forceinline__ s16x4 tr_read(int vb) {
  s16x4 r; asm volatile("ds_read_b64_tr_b16 %0, %1 offset:%2" : "=&v"(r) : "v"(vb), "i"(OFF) : "memory"); return r;
}
template <int D0> __device__ __forceinline__ void pv_one(f32x16& od, int vb, f16x8 pa0, f16x8 pa1, f16x8 pa2, f16x8 pa3) {
  const s16x4 l0 = tr_read<v_rd_off(D0, 0, 0)>(vb), h0 = tr_read<v_rd_off(D0, 0, 1)>(vb), l1 = tr_read<v_rd_off(D0, 1, 0)>(vb), h1 = tr_read<v_rd_off(D0, 1, 1)>(vb);
  const s16x4 l2 = tr_read<v_rd_off(D0, 2, 0)>(vb), h2 = tr_read<v_rd_off(D0, 2, 1)>(vb), l3 = tr_read<v_rd_off(D0, 3, 0)>(vb), h3 = tr_read<v_rd_off(D0, 3, 1)>(vb);
  asm volatile("s_waitcnt lgkmcnt(0)" ::: "memory"); SBAR();
  typedef short s16x8 __attribute__((ext_vector_type(8)));
#define PK(L, H) __builtin_bit_cast(f16x8, (s16x8){L[0], L[1], L[2], L[3], H[0], H[1], H[2], H[3]})
  od = __builtin_amdgcn_mfma_f32_32x32x16_f16(pa0, PK(l0, h0), od, 0, 0, 0);
  od = __builtin_amdgcn_mfma_f32_32x32x16_f16(pa1, PK(l1, h1), od, 0, 0, 0);
  od = __builtin_amdgcn_mfma_f32_32x32x16_f16(pa2, PK(l2, h2), od, 0, 0, 0);
  od = __builtin_amdgcn_mfma_f32_32x32x16_f16(pa3, PK(l3, h3), od, 0, 0, 0);
#undef PK
}
__device__ __forceinline__ void pv_d0(f32x16* o, int vb, f16x8 pa0, f16x8 pa1, f16x8 pa2, f16x8 pa3) {
  pv_one<0>(o[0], vb, pa0, pa1, pa2, pa3); pv_one<1>(o[1], vb, pa0, pa1, pa2, pa3); pv_one<2>(o[2], vb, pa0, pa1, pa2, pa3); pv_one<3>(o[3], vb, pa0, pa1, pa2, pa3);
}

template <int MODE, int PART>
__device__ __forceinline__ void attn_body(const f16* Qb, const f16* __restrict__ KV, int kcol, int vcol, int NT, int tfirst, int tstart, int Tlast, int mrow, int rbase,
                                          int qoff, int wlo, int whi, int Sm1, float sink, int nvalid, float* part, char* lds, int swid) {
  const int tid = opaque_tid(swid), wid = tid >> 6, lane = tid & 63, r32 = lane & 31, hi = lane >> 5;
  char* V_lds = lds; char* K_lds = lds + 2 * SHM_V;
  float* wsf = (float*)(lds + 2 * SHM_V + 2 * SHM_K) + wid * 64; float* li_l = wsf; float* al_l = wsf + 32;
  float m_reg = -1e30f, l_reg = 0; f32x16 o[4] = {}; f16x8 qr[8];
  const f16* Qw = Qb + (size_t)(wid * 32 + r32) * LDQ + hi * 8;
#pragma unroll
  for (int d0 = 0; d0 < 8; ++d0) qr[d0] = *reinterpret_cast<const f16x8*>(Qw + d0 * 16);
  const int sr = tid >> 4, sc = (tid & 15) * 8, vst0 = v_st(sr, sc), vst1 = v_st(32 + sr, sc);
  const int vb0 = (int)(uintptr_t)V_lds + v_rd_base(lane);
  const f16* Kh = KV + kcol; const f16* Vh = KV + vcol;
  struct { f16x8 vs0, vs1, ks0, ks1; } sr_[2];
#define TIDX(j) ((j) == 0 ? tfirst : (tstart + (j)))
#define KROW(j) ({ int _t = TIDX(j); _t = _t >= Tlast ? Tlast - 1 : _t; (_t <= 0) ? mrow : rbase + (_t - 1) * KVBLK; })
#define SLOAD(i, j) do { const int _k0 = KROW(j); sr_[i].vs0 = *(const f16x8*)&Vh[(size_t)(_k0 + sr) * LDQ + sc]; sr_[i].vs1 = *(const f16x8*)&Vh[(size_t)(_k0 + 32 + sr) * LDQ + sc]; \
    sr_[i].ks0 = *(const f16x8*)&Kh[(size_t)(_k0 + sr) * LDQ + sc]; sr_[i].ks1 = *(const f16x8*)&Kh[(size_t)(_k0 + 32 + sr) * LDQ + sc]; } while (0)
#define SWRITE(b, i) do { *(f16x8*)(V_lds + (b) * SHM_V + vst0) = sr_[i].vs0;          \
    *(f16x8*)(V_lds + (b) * SHM_V + vst1) = sr_[i].vs1; const int kc = sc * 2;               \
    *(f16x8*)(K_lds + (b) * SHM_K + KSWZ(sr, kc)) = sr_[i].ks0;                       \
    *(f16x8*)(K_lds + (b) * SHM_K + KSWZ(32 + sr, kc)) = sr_[i].ks1; } while (0)
#define SWAIT() asm volatile("s_waitcnt vmcnt(4)" ::: "memory")
#define RESC(a) do { if (__any((a) < 1.f)) { if (hi == 0) al_l[r32] = (a); asm volatile("s_waitcnt lgkmcnt(0)" ::: "memory"); \
    _Pragma("unroll") for (int d = 0; d < 4; ++d) _Pragma("unroll") for (int r = 0; r < 16; ++r) o[d][r] *= al_l[crow(r, hi)]; } } while (0)
#define MASKJ(P0, P1, j) do { if (MODE == 1) { const int _kb = (TIDX(j) - 1) * KVBLK; const int _qi = qoff + wid * 32 + r32; int _lo = _qi - wlo; _lo = _lo < 0 ? 0 : _lo; int _hi = _qi + whi; _hi = _hi > Sm1 ? Sm1 : _hi; \
    mask_tile(P0, P1, _lo - _kb, _hi - _kb, hi); } } while (0)
  f32x16 pA0, pA1, pB0, pB1; float mnA, mnB, alA, alB; f16x8 pa0, pa1, pa2, pa3;
  constexpr int SE = 0, SO = 1;
  SLOAD(SE, 0); asm volatile("s_waitcnt vmcnt(0)" ::: "memory"); SWRITE(0, SE); __syncthreads();
  qkt(pA0, pA1, K_lds, qr, r32, hi); if (tfirst == 0) mask_tile(pA0, pA1, 0, 15, hi); partialSM(pA0, pA1, m_reg, mnA, alA);
  SLOAD(SO, 1); if (2 < NT) SLOAD(SE, 2);
  SWAIT(); SWRITE(1, SO); __syncthreads();
  for (int j = 1; j + 1 < NT; j += 2) {
    SBAR(); qkt(pB0, pB1, K_lds + SHM_K, qr, r32, hi); MASKJ(pB0, pB1, j);
    finishSM(pA0, pA1, alA, l_reg, pa0, pa1, pa2, pa3); SBAR();
    SLOAD(SO, j + 2); SBAR();
    pv_d0(o, vb0, pa0, pa1, pa2, pa3); partialSM(pB0, pB1, m_reg, mnB, alB);
    __syncthreads(); SWAIT(); SWRITE(0, SE);
    RESC(alB); __syncthreads();
    SBAR(); qkt(pA0, pA1, K_lds, qr, r32, hi); MASKJ(pA0, pA1, j + 1);
    finishSM(pB0, pB1, alB, l_reg, pa0, pa1, pa2, pa3); SBAR();
    if (j + 3 < NT) SLOAD(SE, j + 3); SBAR();
    pv_d0(o, vb0 + SHM_V, pa0, pa1, pa2, pa3); partialSM(pA0, pA1, m_reg, mnA, alA);
    __syncthreads(); SWAIT(); SWRITE(1, SO);
    RESC(alA); __syncthreads();
  }
  SBAR(); qkt(pB0, pB1, K_lds + SHM_K, qr, r32, hi);
  if (MODE == 0) { if (tstart + NT - 1 == Tlast) mask_tile(pB0, pB1, 1, 0, hi); } else MASKJ(pB0, pB1, NT - 1);
  finishSM(pA0, pA1, alA, l_reg, pa0, pa1, pa2, pa3); SBAR();
  pv_d0(o, vb0, pa0, pa1, pa2, pa3); partialSM(pB0, pB1, m_reg, mnB, alB);
  __syncthreads(); RESC(alB);
  finishSM(pB0, pB1, alB, l_reg, pa0, pa1, pa2, pa3); SBAR();
  pv_d0(o, vb0 + SHM_V, pa0, pa1, pa2, pa3);
  if (MODE == 1) l_reg += __builtin_amdgcn_exp2f(sink * 1.4426950408889634f - m_reg * (ASCALE * 1.4426950408889634f));
  if (hi == 0) li_l[r32] = l_reg; asm volatile("s_waitcnt lgkmcnt(0)" ::: "memory");
  float rli[16];
#pragma unroll
  for (int r = 0; r < 16; ++r) rli[r] = __builtin_amdgcn_rcpf(li_l[crow(r, hi)]);
  if (PART == 0) {
    f16* Ow = const_cast<f16*>(Qb) + (size_t)(wid * 32) * LDQ;
#pragma unroll
    for (int r = 0; r < 16; ++r) { const int orow = crow(r, hi);
      if (wid * 32 + orow < nvalid) {
#pragma unroll
        for (int d0 = 0; d0 < 4; ++d0) Ow[(size_t)orow * LDQ + d0 * 32 + r32] = (f16)(o[d0][r] * rli[r]); } }
  } else {
    if (wid == 0) {
#pragma unroll
      for (int r = 0; r < 16; ++r) { const int orow = crow(r, hi);
        if (orow < 16) {
#pragma unroll
          for (int d0 = 0; d0 < 4; ++d0) part[orow * 128 + d0 * 32 + r32] = o[d0][r] * rli[r]; } }
      if (lane < 16) { part[2048 + lane] = m_reg; part[2064 + lane] = l_reg; }
    }
  }
  __syncthreads();
#undef SLOAD
#undef SWRITE
#undef SWAIT
#undef RESC
#undef MASKJ
#undef TIDX
#undef KROW
}

constexpr int PART_FLOATS = 2080;
#ifndef SPLITKV
#define SPLITKV 0
#endif
constexpr int CHUNK_T = 6;
__device__ __forceinline__ void phase_attn(const Args& a, const Round& R, int l, unsigned* counter, char* lds, int dry, int swid) {
  f16* U = (f16*)(a.ws + WS_U);
  float* PART = (float*)(a.ws + WS_PART);
  const int NQB = R.S / 256, per_seq = 8 * NQB;
  const int Tlast = R.S / 64 + 1, nchunk = (Tlast + 1) / CHUNK_T;
  const int nreal = R.nseq * per_seq, nmeta = (l == 0) ? R.nseq * 8 : 0, nmc = SPLITKV ? nmeta * nchunk : nmeta;
  const int total = nmc + 2 * nreal + nmeta;
  const int tid_ = opaque_tid(swid);
  unsigned* slot = (unsigned*)(lds + 131072);
  for (;;) {
    if (tid_ == 0) *slot = atomicAdd(counter, 1u);
    __syncthreads();
    const int idx = (int)*slot;
    __syncthreads();
    if (idx >= total) break;
    if (!SPLITKV && idx < nmc) {
      const int s = idx >> 3, head = idx & 7;
      const f16* Q = U + (size_t)(16 * s) * INW + C_QA + head * 128;
      attn_body<0, 0>(Q, U, C_KA + (head >> 2) * 128, C_VA + (head >> 2) * 128, Tlast + 1, 0, 0, Tlast, 16 * s, RB + R.S * s, 0, 0, 0, 0, 0.f, dry ? 0 : 16, nullptr, lds, swid);
      continue;
    }
    if (SPLITKV && idx < nmc) {
      const int u = idx / nchunk, c = idx - u * nchunk, s = u >> 3, head = u & 7;
      const f16* Q = U + (size_t)(16 * s) * INW + C_QA + head * 128;
      attn_body<0, 1>(Q, U, C_KA + (head >> 2) * 128, C_VA + (head >> 2) * 128, CHUNK_T, c * CHUNK_T, c * CHUNK_T, Tlast, 16 * s, RB + R.S * s,
                      0, 0, 0, 0, 0.f, 0, PART + (size_t)idx * PART_FLOATS, lds, swid);
      continue;
    }
    int k = idx - nmc;
    if (k < nreal) {
      const int s = k / per_seq, rem = k - s * per_seq, head = rem / NQB, qb = rem - head * NQB;
      const f16* Q = U + (size_t)(RB + R.S * s + qb * 256) * INW + C_QA + head * 128;
      attn_body<0, 0>(Q, U, C_KA + (head >> 2) * 128, C_VA + (head >> 2) * 128, Tlast + 1, 0, 0, Tlast, 16 * s, RB + R.S * s, 0, 0, 0, 0, 0.f, dry ? 0 : 256, nullptr, lds, swid);
      continue;
    }
    k -= nreal;
    int meta, s, head, qb;
    if (k < nreal) { meta = 0; s = k / per_seq; const int rem = k - s * per_seq; head = rem / NQB; qb = rem - head * NQB; }
    else { meta = 1; k -= nreal; s = k >> 3; head = k & 7; qb = 0; }
    const f16* Q = U + (size_t)(meta ? 16 * s : RB + R.S * s + qb * 256) * INW + C_QB + head * 128;
    const float sink = a.sink[l * 8 + head];
    attn_body<1, 0>(Q, U, C_KB + (head >> 2) * 128, C_VB + (head >> 2) * 128, meta ? 4 : 10, 0, meta ? 0 : qb * 4 - 2, Tlast, 16 * s, RB + R.S * s,
                    qb * 256, meta ? (1 << 24) : 128, meta ? 112 : 128, R.S - 1, sink, dry ? 0 : (meta ? 16 : 256), nullptr, lds, swid);
  }
}
__device__ __forceinline__ void phase_combine(const Args& a, const Round& R, int swid) {
  f16* U = (f16*)(a.ws + WS_U); const float* PART = (const float*)(a.ws + WS_PART);
  const int Tlast = R.S / 64 + 1, nchunk = (Tlast + 1) / CHUNK_T;
  const int tid_ = opaque_tid(swid); const int wid = tid_ >> 6, lane = tid_ & 63;
  constexpr float C = ASCALE * 1.4426950408889634f;
  for (int it = blockIdx.x * 8 + wid; it < R.nseq * 8 * 16; it += gridDim.x * 8) {
    const int u = it >> 4, m = it & 15, s = u >> 3, head = u & 7;
    const float* p0 = PART + (size_t)u * nchunk * PART_FLOATS;
    float mx = -1e30f;
    for (int c = 0; c < nchunk; ++c) mx = fmaxf(mx, p0[(size_t)c * PART_FLOATS + 2048 + m]);
    float wsum = 0.f, o0 = 0.f, o1 = 0.f;
    for (int c = 0; c < nchunk; ++c) { const float* p = p0 + (size_t)c * PART_FLOATS;
      const float w = p[2064 + m] * __builtin_amdgcn_exp2f((p[2048 + m] - mx) * C);
      wsum += w; o0 += w * p[m * 128 + lane]; o1 += w * p[m * 128 + 64 + lane]; }
    const float rw = 1.0f / wsum;
    f16* dst = U + (size_t)(16 * s + m) * INW + C_QA + head * 128;
    dst[lane] = (f16)(o0 * rw); dst[64 + lane] = (f16)(o1 * rw);
  }
}

#ifndef PROBE
#define PROBE 0
#endif
#define RELAUNDER() do { } while (0)
__global__ void __launch_bounds__(NTHR, 2) mega(Args a) {
  extern __shared__ __attribute__((aligned(16))) unsigned char lds[];
  cg::grid_group grid = cg::this_grid();
  const int swid = __builtin_amdgcn_readfirstlane((int)(threadIdx.x >> 6));
  volatile LAS unsigned* bst = (volatile LAS unsigned*)((LAS unsigned char*)lds + 131072 + 64);
  if (threadIdx.x < 2) bst[threadIdx.x] = 0u;
  __syncthreads();
  const XcdBarrier xbar = xcd_barrier_post((unsigned*)(a.ws + WS_BAR), bst, (int)threadIdx.x);
  phase_weights(a, (float*)lds, swid);
  { const Round R0 = get_round(0); phase_rows(a, R0, 0, nullptr, nullptr, 0, swid); }
  grid.sync();
  LAS unsigned char* ldsl = (LAS unsigned char*)lds;
  for (int r = 0; r < 4; ++r) {
    const Round R = get_round(r);
    const int nM = 64;
    for (int l = 0; l < 2; ++l) {
      RELAUNDER();
      meta_gemm<1>(a, l, (float*)lds, swid);
      { Sched<1> S{a.ws, l, nM, (int)gridDim.x, (int)blockIdx.x}; EpiU E{0, a.ws}; gemm_phase<DM * 2, DM * 2, 16>(ldsl, S, E, swid);
        if (PROBE == 1) gemm_phase<DM * 2, DM * 2, 16>(ldsl, S, E, swid); }
      xcd_barrier(xbar, swid); RELAUNDER();
      phase_prep(a, R, l, 0, swid);
      if (PROBE == 3) phase_prep(a, R, l, a.dry_on, swid);
      xcd_barrier(xbar, swid); RELAUNDER();
      phase_attn(a, R, l, (unsigned*)(a.ws + WS_CTL) + (r * 2 + l) * 64, (char*)lds, 0, swid);
      if (PROBE == 2) phase_attn(a, R, l, (unsigned*)(a.ws + WS_CTL) + (r * 2 + l) * 64 + 32, (char*)lds, a.dry_on, swid);
      xcd_barrier(xbar, swid); RELAUNDER();
      if (SPLITKV && l == 0) { phase_combine(a, R, swid); xcd_barrier(xbar, swid); RELAUNDER(); }
      meta_gemm<4>(a, l, (float*)lds, swid);
      for (int rep = 0; rep < (PROBE == 1 ? 2 : 1); ++rep) {
      { Sched<40> S{a.ws, l, nM, (int)gridDim.x, (int)blockIdx.x}; EpiGate<0> E{0, a.ws}; gemm_phase<INW * 2, DM * 2, 16>(ldsl, S, E, swid); }
      { Sched<41> S{a.ws, l, nM, (int)gridDim.x, (int)blockIdx.x}; EpiGate<1> E{0, a.ws}; gemm_phase<INW * 2, DM * 2, 16>(ldsl, S, E, swid); }
      { Sched<42> S{a.ws, l, nM, (int)gridDim.x, (int)blockIdx.x}; EpiGate<2> E{0, a.ws}; gemm_phase<DM * 2, 256 * 2, 4>(ldsl, S, E, swid); }
      }
      xcd_barrier(xbar, swid); RELAUNDER();
      meta_gemm<5>(a, l, (float*)lds, swid);
      { Sched<5> S{a.ws, l, nM, (int)gridDim.x, (int)blockIdx.x}; EpiResid E{0, a.ws}; gemm_phase<DM * 2, DM * 2, 16>(ldsl, S, E, swid);
        if (PROBE == 1) { E.dry = a.dry_on; gemm_phase<DM * 2, DM * 2, 16>(ldsl, S, E, swid); } }
      xcd_barrier(xbar, swid); RELAUNDER();
      phase_rows(a, R, 1, a.ln1g + l * DM, a.ln1b + l * DM, -1, swid);
      if (PROBE == 3) phase_rows(a, R, 1, a.ln1g + l * DM, a.ln1b + l * DM, -1, swid, a.dry_on);
      xcd_barrier(xbar, swid); RELAUNDER();
      meta_gemm<7>(a, l, (float*)lds, swid);
      { Sched<7> S{a.ws, l, nM, (int)gridDim.x, (int)blockIdx.x}; EpiSwiglu E{0, a.ws}; gemm_phase<DM * 2, DM * 2, 16>(ldsl, S, E, swid);
        if (PROBE == 1) gemm_phase<DM * 2, DM * 2, 16>(ldsl, S, E, swid); }
      xcd_barrier(xbar, swid); RELAUNDER();
      meta_gemm<8>(a, l, (float*)lds, swid);
      { Sched<8> S{a.ws, l, nM, (int)gridDim.x, (int)blockIdx.x}; EpiResid E{0, a.ws}; gemm_phase<DFF * 2, DFF * 2, 44>(ldsl, S, E, swid);
        if (PROBE == 1) { E.dry = a.dry_on; gemm_phase<DFF * 2, DFF * 2, 44>(ldsl, S, E, swid); } }
      xcd_barrier(xbar, swid); RELAUNDER();
      if (PROBE == 3) phase_rows(a, R, 1, a.ln2g + l * DM, a.ln2b + l * DM, -1, swid, a.dry_on);
      if (l == 0) phase_rows(a, R, 1, a.ln2g + l * DM, a.ln2b + l * DM, -1, swid);
      else phase_rows(a, R, 2, a.ln2g + l * DM, a.ln2b + l * DM, r < 3 ? r + 1 : -1, swid);
      xcd_barrier(xbar, swid); RELAUNDER();
    }
  }
}

extern "C" void kernel_launch(void* const* d_in, const int* in_sizes, int n_in, void* d_out, int out_size, void* d_ws, size_t ws_size, hipStream_t stream) {
  static int grid_blocks = 0;
  if (grid_blocks == 0) {
    if (n_in != 18 || ws_size < WS_END) { fprintf(stderr, "kernel_launch: n_in %d ws %zu (need %zu)\n", n_in, ws_size, (size_t)WS_END); grid_blocks = -1; return; }
    int dev = 0, cus = 0, per_cu = 0;
    hipGetDevice(&dev);
    hipDeviceGetAttribute(&cus, hipDeviceAttributeMultiprocessorCount, dev);
    if (hipFuncSetAttribute((const void*)mega, hipFuncAttributeMaxDynamicSharedMemorySize, LDS_BYTES) != hipSuccess) { fprintf(stderr, "kernel_launch: hipFuncSetAttribute failed\n"); grid_blocks = -1; return; }
    hipOccupancyMaxActiveBlocksPerMultiprocessor(&per_cu, (const void*)mega, NTHR, LDS_BYTES);
    if (per_cu < 1) { fprintf(stderr, "kernel_launch: occupancy query gave %d\n", per_cu); per_cu = 1; }
    if (per_cu > 1) per_cu = 1;
    grid_blocks = cus * per_cu;
  }
  if (grid_blocks < 0) return;
  (void)hipMemsetAsync((char*)d_ws + WS_CTL, 0, CTL_BYTES, stream);
  Args a{};
  a.x_prompt = (const float*)d_in[0]; a.x_sample = (const float*)d_in[1]; a.meta = (const float*)d_in[2]; a.w_in = (const float*)d_in[3];
  a.qg = (const float*)d_in[4]; a.kg = (const float*)d_in[5]; a.sink = (const float*)d_in[6]; a.pool_w = (const float*)d_in[7]; a.pool_scale = (const float*)d_in[8];
  a.w_a = (const float*)d_in[9]; a.w_b = (const float*)d_in[10]; a.w_out = (const float*)d_in[11]; a.ln1g = (const float*)d_in[12]; a.ln1b = (const float*)d_in[13];
  a.w_up = (const float*)d_in[14]; a.w_down = (const float*)d_in[15]; a.ln2g = (const float*)d_in[16]; a.ln2b = (const float*)d_in[17];
  a.out = (float*)d_out; a.ws = (unsigned char*)d_ws; a.dry_on = 1; a.pad = 0;
  void* args[] = {&a};
  hipError_t e = hipLaunchCooperativeKernel((const void*)mega, dim3(grid_blocks), dim3(NTHR), args, LDS_BYTES, stream);
  if (e != hipSuccess) fprintf(stderr, "cooperative launch failed: %s (grid %d)\n", hipGetErrorString(e), grid_blocks);
}
```

```cpp
#include <hip/hip_runtime.h>
#include <hip/hip_cooperative_groups.h>
#include <cstdio>
namespace cg = cooperative_groups;

#define LAS __attribute__((address_space(3)))
typedef _Float16 f16;
typedef _Float16 f16x8 __attribute__((ext_vector_type(8)));
typedef _Float16 f16x4 __attribute__((ext_vector_type(4)));
typedef _Float16 f16x2 __attribute__((ext_vector_type(2)));
typedef float f32x4 __attribute__((ext_vector_type(4)));
typedef float f32x16 __attribute__((ext_vector_type(16)));
typedef unsigned u32x4 __attribute__((ext_vector_type(4)));
typedef unsigned u32x2 __attribute__((ext_vector_type(2)));

__device__ __forceinline__ int opaque_tid(int swid) { int t = swid * 64 + (int)__builtin_amdgcn_mbcnt_hi(~0u, __builtin_amdgcn_mbcnt_lo(~0u, 0u)); asm volatile("" : "+v"(t)); return t; }

constexpr int DM = 1024, INW = 7168, DFF = 2816, NUP = 5632;
constexpr int RB = 128;
constexpr int MROWS = RB + 16384;
constexpr int C_QA = 0, C_KA = 1024, C_VA = 1280, C_QB = 1536, C_KB = 2560, C_VB = 2816, C_UC = 3072, C_UG = 4096;
constexpr float ALPHA = 1.4142135623730951f;
constexpr int NTHR = 512;

constexpr size_t WS_CTL = 0;
constexpr size_t WS_BAR = 4096;
constexpr size_t CTL_BYTES = 32768;
constexpr size_t WS_WIN = CTL_BYTES;
constexpr size_t WS_WA  = WS_WIN + (size_t)2 * INW * DM * 2;
constexpr size_t WS_WB  = WS_WA + (size_t)2 * DM * DM * 2;
constexpr size_t WS_WO  = WS_WB + (size_t)2 * DM * DM * 2;
constexpr size_t WS_WP  = WS_WO + (size_t)2 * DM * DM * 2;
constexpr size_t WS_WUP = WS_WP + (size_t)2 * 4 * 256 * 256 * 2;
constexpr size_t WS_WDN = WS_WUP + (size_t)2 * NUP * DM * 2;
constexpr size_t WS_U   = WS_WDN + (size_t)2 * DM * DFF * 2;
constexpr size_t WS_PD  = WS_U + (size_t)MROWS * INW * 2;
constexpr size_t WS_MG  = WS_PD + (size_t)MROWS * DM * 2;
constexpr size_t WS_H16 = WS_MG + (size_t)MROWS * DM * 2;
constexpr size_t WS_H32 = WS_H16 + (size_t)MROWS * DM * 2;
constexpr size_t WS_PART = WS_H32 + (size_t)MROWS * DM * 4;
constexpr size_t WS_END = WS_PART + (size_t)352 * 2080 * 4;
constexpr int LDS_BYTES = 131072 + 256;

struct Args {
  const float* x_prompt; const float* x_sample; const float* meta; const float* w_in; const float* qg; const float* kg; const float* sink;
  const float* pool_w; const float* pool_scale; const float* w_a; const float* w_b; const float* w_out; const float* ln1g; const float* ln1b;
  const float* w_up; const float* w_down; const float* ln2g; const float* ln2b;
  float* out; unsigned char* ws; int dry_on; int pad;
};

struct Round { int nseq, S, is_sample, b0; };
__device__ __forceinline__ Round get_round(int r) {
  Round R;
  if (r < 2) { R.nseq = 4; R.S = 4096; R.is_sample = 0; R.b0 = r * 4; }
  else       { R.nseq = 1; R.S = 16384; R.is_sample = 1; R.b0 = r & 1; }
  return R;
}

#define XB_TMO      128
#define XB_XCNT(j)  (256  + 64 * (j))
#define XB_XSUB(j)  (1280 + 64 * (j))
#define XB_XGEN(j)  (2304 + 64 * (j))
#define XB_TOP      3328
#define XB_TOPGEN   3392
#define XCD_BAR_WORDS 3456
#define XB_SPIN_CAP (1u << 22)
__device__ __forceinline__ unsigned xb_ld(unsigned* p)              { return __hip_atomic_load(p, __ATOMIC_RELAXED, __HIP_MEMORY_SCOPE_AGENT); }
__device__ __forceinline__ unsigned xb_add(unsigned* p, unsigned v) { return __hip_atomic_fetch_add(p, v, __ATOMIC_RELAXED, __HIP_MEMORY_SCOPE_AGENT); }
__device__ __forceinline__ unsigned xb_xcc_id() { return (unsigned)__builtin_amdgcn_s_getreg((3 << 11) | 20) & 0xFu; }
#define XB_SPIN(cond, bar) do { unsigned _sp = 0; while (cond) { __builtin_amdgcn_s_sleep(1); \
    if ((++_sp & 255u) == 0u) { if (xb_ld(&(bar)[XB_TMO])) break; if (_sp > XB_SPIN_CAP) { atomicAdd(&(bar)[XB_TMO], 1u); break; } } } } while (0)
struct XcdBarrier { unsigned* bar; unsigned x; volatile LAS unsigned* st; };
__device__ __forceinline__ XcdBarrier xcd_barrier_post(unsigned* bar, volatile LAS unsigned* st, int tid) {
  XcdBarrier b; b.bar = bar; b.x = xb_xcc_id(); b.st = st;
  if (tid == 0) (void)xb_add(&bar[XB_XCNT(b.x)], 1u);
  return b;
}
__device__ __forceinline__ void xcd_barrier_complete(unsigned* bar, unsigned x, unsigned& nloc, unsigned& nx) {
  const unsigned G = gridDim.x * gridDim.y * gridDim.z;
  unsigned sum, cnt, mine, sp = 0u;
  for (;;) {
    sum = 0u; cnt = 0u; mine = 0u;
#pragma unroll
    for (unsigned j = 0; j < 16; ++j) { const unsigned c = xb_ld(&bar[XB_XCNT(j)]); sum += c; cnt += (c > 0u) ? 1u : 0u; mine = (j == x) ? c : mine; }
    if (sum == G) break;
    __builtin_amdgcn_s_sleep(1);
    if ((++sp & 255u) == 0u) { if (xb_ld(&bar[XB_TMO])) break; if (sp > XB_SPIN_CAP) { atomicAdd(&bar[XB_TMO], 1u); break; } }
  }
  nloc = mine > 0u ? mine : 1u; nx = cnt > 0u ? cnt : 1u;
}
__device__ __forceinline__ void xcd_barrier(const XcdBarrier& b, int swid) {
  asm volatile("s_waitcnt vmcnt(0)" ::: "memory");
  __syncthreads();
  if (opaque_tid(swid) == 0) {
    unsigned* bar = b.bar;
    __builtin_amdgcn_s_waitcnt(0);
    unsigned nloc = b.st[0], nx = b.st[1];
    if (nloc == 0u) { xcd_barrier_complete(bar, b.x, nloc, nx); b.st[0] = nloc; b.st[1] = nx; }
    const unsigned old = xb_add(&bar[XB_XSUB(b.x)], 1u);
    const unsigned gen = old / nloc;
    if (old + 1u == (gen + 1u) * nloc) {
      __builtin_amdgcn_fence(__ATOMIC_RELEASE, "agent");
      asm volatile("s_waitcnt vmcnt(0)" ::: "memory");
      const unsigned og = xb_add(&bar[XB_TOP], 1u);
      const unsigned tg = og / nx;
      if (og + 1u == (tg + 1u) * nx) xb_add(&bar[XB_TOPGEN], 1u);
      else XB_SPIN(xb_ld(&bar[XB_TOPGEN]) == tg, bar);
      __builtin_amdgcn_fence(__ATOMIC_ACQUIRE, "agent");
      xb_add(&bar[XB_XGEN(b.x)], 1u);
      asm volatile("s_waitcnt vmcnt(0)" ::: "memory");
    } else {
      XB_SPIN(xb_ld(&bar[XB_XGEN(b.x)]) == gen, bar);
      __builtin_amdgcn_fence(__ATOMIC_ACQUIRE, "agent");
      asm volatile("s_waitcnt vmcnt(0)" ::: "memory");
    }
  }
  __syncthreads();
}

__device__ __forceinline__ void tp_tile(const float* __restrict__ src, int lds_, int k0, int n0, f16* __restrict__ dst, int ldd, int drow0,
                                        const float* __restrict__ scale, float* tile, int swid) {
  const int t = opaque_tid(swid);
#pragma unroll
  for (int p = 0; p < 2; ++p) {
    const int r = (t >> 4) + 32 * p, c4 = (t & 15) * 4;
    const f32x4 v = *(const f32x4*)(src + (size_t)(k0 + r) * lds_ + n0 + c4);
    tile[r * 65 + c4 + 0] = v[0]; tile[r * 65 + c4 + 1] = v[1]; tile[r * 65 + c4 + 2] = v[2]; tile[r * 65 + c4 + 3] = v[3];
  }
  __syncthreads();
  {
    const int n = t >> 3, k8 = (t & 7) * 8;
    const float sc = scale ? scale[n0 + n] : 1.0f;
    f16x8 o;
#pragma unroll
    for (int i = 0; i < 8; ++i) o[i] = (f16)(tile[(k8 + i) * 65 + n] * sc);
    *(f16x8*)(dst + (size_t)(drow0 + n) * ldd + k0 + k8) = o;
  }
  __syncthreads();
}

__device__ __forceinline__ void phase_weights(const Args& a, float* tile, int swid) {
  constexpr int T_IN = 16 * 112, T_SQ = 16 * 16, T_UP = 16 * 88, T_DN = 44 * 16, T_PL = 4 * 16;
  constexpr int T_LAYER = T_IN + 3 * T_SQ + T_UP + T_DN + T_PL;
  unsigned char* ws = a.ws;
  for (int idx = blockIdx.x; idx < 2 * T_LAYER; idx += gridDim.x) {
    const int l = idx / T_LAYER; int j = idx % T_LAYER;
    if (j < T_IN) { const int kt = j / 112, nt = j % 112;
      tp_tile(a.w_in + (size_t)l * DM * INW, INW, kt * 64, nt * 64, (f16*)(ws + WS_WIN) + (size_t)l * INW * DM, DM, nt * 64, nullptr, tile, swid); continue; }
    j -= T_IN;
    if (j < 3 * T_SQ) { const int w = j / T_SQ, jj = j % T_SQ, kt = jj / 16, nt = jj % 16;
      const float* src = (w == 0 ? a.w_a : (w == 1 ? a.w_b : a.w_out)) + (size_t)l * DM * DM;
      f16* dst = (f16*)(ws + (w == 0 ? WS_WA : (w == 1 ? WS_WB : WS_WO))) + (size_t)l * DM * DM;
      tp_tile(src, DM, kt * 64, nt * 64, dst, DM, nt * 64, nullptr, tile, swid); continue; }
    j -= 3 * T_SQ;
    if (j < T_UP) { const int kt = j / 88, nt = j % 88; const int n0 = nt * 64, bj = n0 / DFF, rem = n0 % DFF, p = rem / 128, j0 = rem % 128;
      tp_tile(a.w_up + (size_t)l * DM * NUP, NUP, kt * 64, n0, (f16*)(ws + WS_WUP) + (size_t)l * NUP * DM, DM, p * 256 + bj * 128 + j0, nullptr, tile, swid); continue; }
    j -= T_UP;
    if (j < T_DN) { const int kt = j / 16, nt = j % 16;
      tp_tile(a.w_down + (size_t)l * DFF * DM, DM, kt * 64, nt * 64, (f16*)(ws + WS_WDN) + (size_t)l * DM * DFF, DFF, nt * 64, nullptr, tile, swid); continue; }
    j -= T_DN;
    { const int g = j / 16, jj = j % 16, kt = jj / 4, nt = jj % 4;
      tp_tile(a.pool_w + ((size_t)l * 4 + g) * 256 * 256, 256, kt * 64, nt * 64, (f16*)(ws + WS_WP) + ((size_t)l * 4 + g) * 256 * 256, 256, nt * 64,
              a.pool_scale + (size_t)l * DM + g * 256, tile, swid); }
  }
}

__device__ __forceinline__ int row_kind(const Round& R, int row, int& s, int& o) {
  if (row < 64) { s = row >> 4; o = row & 15; return s < R.nseq ? 1 : 0; }
  if (row < RB) return 0;
  const int q = row - RB; s = q / R.S; o = q - s * R.S; return 2;
}
__device__ __forceinline__ const float* x_row(const Args& a, const Round& R, int s, int i) {
  return R.is_sample ? a.x_sample + ((size_t)R.b0 * 16384 + i) * DM : a.x_prompt + ((size_t)(R.b0 + s) * 4096 + i) * DM;
}
__device__ __forceinline__ float* out_row(const Args& a, const Round& R, int s, int i) {
  return R.is_sample ? a.out + (size_t)8 * 4096 * DM + ((size_t)R.b0 * 16384 + i) * DM : a.out + ((size_t)(R.b0 + s) * 4096 + i) * DM;
}
__device__ __forceinline__ void store_h(const Args& a, int row, int lane, const f32x4 (&v)[4]) {
  float* h32 = (float*)(a.ws + WS_H32) + (size_t)row * DM; f16* h16 = (f16*)(a.ws + WS_H16) + (size_t)row * DM;
#pragma unroll
  for (int i = 0; i < 4; ++i) { const int c = i * 256 + lane * 4;
    *(f32x4*)(h32 + c) = v[i];
    f16x4 h = {(f16)v[i][0], (f16)v[i][1], (f16)v[i][2], (f16)v[i][3]}; *(f16x4*)(h16 + c) = h; }
}
__device__ __forceinline__ void init_row(const Args& a, const Round& R, int row, int lane) {
  int s = 0, o = 0; const int kd = row_kind(R, row, s, o);
  f32x4 v[4];
  const float* src = kd == 1 ? a.meta + (size_t)o * DM : (kd == 2 ? x_row(a, R, s, o) : nullptr);
#pragma unroll
  for (int i = 0; i < 4; ++i) v[i] = src ? *(const f32x4*)(src + i * 256 + lane * 4) : (f32x4){0.f, 0.f, 0.f, 0.f};
  store_h(a, row, lane, v);
}
__device__ __forceinline__ void ln_row(const Args& a, const Round& R, int row, int lane, const float* __restrict__ g, const float* __restrict__ b, int to_out, int dry) {
  const float* h32 = (const float*)(a.ws + WS_H32) + (size_t)row * DM;
  f32x4 v[4]; float s = 0.f;
#pragma unroll
  for (int i = 0; i < 4; ++i) { v[i] = *(const f32x4*)(h32 + i * 256 + lane * 4); s += (v[i][0] + v[i][1]) + (v[i][2] + v[i][3]); }
#pragma unroll
  for (int o = 32; o >= 1; o >>= 1) s += __shfl_xor(s, o);
  const float mu = s * (1.0f / DM); float q = 0.f;
#pragma unroll
  for (int i = 0; i < 4; ++i) { const f32x4 d = v[i] - mu; q += (d[0] * d[0] + d[1] * d[1]) + (d[2] * d[2] + d[3] * d[3]); }
#pragma unroll
  for (int o = 32; o >= 1; o >>= 1) q += __shfl_xor(q, o);
  const float rstd = 1.0f / sqrtf(q * (1.0f / DM) + 1e-5f);
#pragma unroll
  for (int i = 0; i < 4; ++i) { const f32x4 gg = *(const f32x4*)(g + i * 256 + lane * 4), bb = *(const f32x4*)(b + i * 256 + lane * 4); v[i] = (v[i] - mu) * rstd * gg + bb; }
  if (dry) return;
  if (!to_out) { store_h(a, row, lane, v); return; }
  int sq = 0, o = 0; const int kd = row_kind(R, row, sq, o);
  if (kd == 2) { float* dst = out_row(a, R, sq, o);
#pragma unroll
    for (int i = 0; i < 4; ++i) *(f32x4*)(dst + i * 256 + lane * 4) = v[i]; }
}
__device__ __forceinline__ void phase_rows(const Args& a, const Round& R, int mode, const float* g, const float* b, int rn, int swid, int dry = 0) {
  const int tid_ = opaque_tid(swid); const int wid = tid_ >> 6, lane = tid_ & 63;
  const int nw = gridDim.x * 8;
  if (mode != 0) for (int v = blockIdx.x * 8 + wid; v < MROWS - 64; v += nw) ln_row(a, R, v < 64 ? v : v + 64, lane, g, b, mode == 2, dry);
  if (mode == 1 || rn < 0 || dry) return;
  const Round Rn = get_round(rn);
  for (int v = blockIdx.x * 8 + wid; v < MROWS - 64; v += nw) init_row(a, Rn, v < 64 ? v : v + 64, lane);
}

constexpr int BM = 256, BK = 64, HALF = 128, HTB = HALF * BK * 2, NXCD = 8, WGM = 8;
__device__ __forceinline__ int lds_byte(int r, int c) { const int st = (r >> 4) * 2 + (c >> 5), rr = r & 15, cc = c & 31, ob = rr * 64 + cc * 2; return st * 1024 + (ob ^ (((ob >> 9) & 1) << 5)); }
__device__ __forceinline__ void stage_rc(int b, int& R, int& C) { const int st = b / 1024, sb = b % 1024, swz = sb ^ (((sb >> 9) & 1) << 5); R = (st >> 1) * 16 + swz / 64; C = (st & 1) * 32 + (swz % 64) / 2; }

struct GUnit { const char* A; const char* B; int pm, pn; };

__device__ __forceinline__ void tile_map(int L, int nM, int nN, int& pm, int& pn) {
  const int nwg = nM * nN; int wgid = L;
  { const int q = nwg / NXCD, r = nwg % NXCD, xcd = wgid % NXCD, off = wgid / NXCD; wgid = (xcd < r ? xcd * (q + 1) : r * (q + 1) + (xcd - r) * q) + off; }
  const int nig = WGM * nN, gid = wgid / nig, fm = gid * WGM, gsz = (nM - fm) < WGM ? (nM - fm) : WGM;
  pm = fm + ((wgid % nig) % gsz); pn = (wgid % nig) / gsz;
}

template <int LDA2, int LDB2, int NT, class Sched, class Epi>
__device__ __forceinline__ void gemm_phase(LAS unsigned char* lds, const Sched& S, const Epi& E, int swid) {
  const int tid = opaque_tid(swid), wid = __builtin_amdgcn_readfirstlane(tid >> 6), lane = tid & 63, wr = wid >> 2, wc = wid & 3, fr = lane & 15, fq = lane >> 4;
  unsigned voffA[2], voffB[2];
#pragma unroll
  for (int i = 0; i < 2; ++i) { int R, C; stage_rc(tid * 16 + i * 8192, R, C); voffA[i] = (unsigned)(R * LDA2 + C * 2); voffB[i] = (unsigned)(R * LDB2 + C * 2); }
  constexpr size_t kstep = (size_t)(BK * 2);
  constexpr size_t hA = (size_t)HALF * LDA2, hB = (size_t)HALF * LDB2;
  const unsigned ldsw = (unsigned)wid * 1024u;
  const int aoff = lds_byte(wr * 64 + fr, fq * 8), boff = lds_byte(wc * 32 + fr, fq * 8);
#define G_SA(b, h) (((b) * 2 + (h)) * HTB)
#define G_SB(b, h) ((4 + (b) * 2 + (h)) * HTB)
#define G_STAGE(bufoff, gbase, voff) do { _Pragma("unroll") for (int _i = 0; _i < 2; ++_i) \
    __builtin_amdgcn_global_load_lds((const unsigned*)((const char*)(gbase) + (voff)[_i]), (LAS unsigned*)(lds + (bufoff) + ldsw + _i * 8192), 16, 0, 0); } while (0)
#define G_LDA(dst, b, h) do { _Pragma("unroll") for (int m = 0; m < 4; ++m) _Pragma("unroll") for (int k = 0; k < 2; ++k) dst[m][k] = *(const LAS f16x8*)(lds + G_SA(b, h) + aoff + m * 2048 + k * 1024); } while (0)
#define G_LDB(dst, b, h) do { _Pragma("unroll") for (int n = 0; n < 2; ++n) _Pragma("unroll") for (int k = 0; k < 2; ++k) dst[n][k] = *(const LAS f16x8*)(lds + G_SB(b, h) + boff + n * 2048 + k * 1024); } while (0)
#define G_MMA(ai, bj, At, Bt) do { __builtin_amdgcn_s_setprio(1); _Pragma("unroll") for (int m = 0; m < 4; ++m) _Pragma("unroll") for (int n = 0; n < 2; ++n) _Pragma("unroll") for (int k = 0; k < 2; ++k) \
    acc[ai][bj][m][n] = __builtin_amdgcn_mfma_f32_16x16x32_f16(Bt[n][k], At[m][k], acc[ai][bj][m][n], 0, 0, 0); __builtin_amdgcn_s_setprio(0); } while (0)
#define G_WAIT_V(n) asm volatile("s_waitcnt vmcnt(" #n ")" ::: "memory")
#define G_WAIT_L(n) asm volatile("s_waitcnt lgkmcnt(" #n ")" ::: "memory")
#define G_BAR __builtin_amdgcn_s_barrier()
#define G_SCHED __builtin_amdgcn_sched_barrier(0)
  GUnit cur, nxt; int ui = 0;
  if (!S.next(0, cur)) return;
  f32x4 acc[2][2][4][2];
#pragma unroll
  for (int a = 0; a < 2; ++a)
#pragma unroll
    for (int b = 0; b < 2; ++b)
#pragma unroll
      for (int m = 0; m < 4; ++m)
#pragma unroll
        for (int n = 0; n < 2; ++n) acc[a][b][m][n] = (f32x4){0.f, 0.f, 0.f, 0.f};
  f16x8 At[4][2], B0[2][2], B1[2][2];
  const char* cA = cur.A; const char* cB = cur.B;
  G_STAGE(G_SB(0, 0), cB, voffB); G_STAGE(G_SA(0, 0), cA, voffA); G_STAGE(G_SB(0, 1), cB + hB, voffB); G_STAGE(G_SA(0, 1), cA + hA, voffA);
  if (wr == 1) G_BAR;
  G_WAIT_V(4); G_BAR;
  G_STAGE(G_SB(1, 0), cB + kstep, voffB); G_STAGE(G_SA(1, 0), cA + kstep, voffA); G_STAGE(G_SB(1, 1), cB + hB + kstep, voffB);
  G_WAIT_V(6); G_BAR;
  for (;;) {
    const bool has_next = S.next(ui + 1, nxt);
    const char* nA = has_next ? nxt.A : cA; const char* nB = has_next ? nxt.B : cB;
#pragma unroll 1
    for (int t = 0; t < NT; t += 2) {
      const bool last = (t == NT - 2);
      const char* a1 = cA + (size_t)(t + 1) * kstep;
      const char* a2 = last ? nA : cA + (size_t)(t + 2) * kstep; const char* b2 = last ? nB : cB + (size_t)(t + 2) * kstep;
      const char* a3 = a2 + kstep; const char* b3 = b2 + kstep;
      G_LDB(B0, 0, 0); G_SCHED; G_LDA(At, 0, 0); G_STAGE(G_SA(1, 1), a1 + hA, voffA);
      G_WAIT_L(8); G_BAR; G_WAIT_L(0); G_MMA(0, 0, At, B0); G_BAR; G_SCHED;
      G_LDB(B1, 0, 1); G_STAGE(G_SB(0, 0), b2, voffB);
      G_BAR; G_WAIT_L(0); G_MMA(0, 1, At, B1); G_BAR;
      G_LDA(At, 0, 1); G_STAGE(G_SA(0, 0), a2, voffA);
      G_BAR; G_WAIT_L(0); G_MMA(1, 0, At, B0); G_BAR; G_SCHED;
      G_STAGE(G_SB(0, 1), b2 + hB, voffB);
      G_WAIT_V(6); G_BAR; G_MMA(1, 1, At, B1); G_BAR;
      G_LDB(B0, 1, 0); G_SCHED; G_LDA(At, 1, 0); G_STAGE(G_SA(0, 1), a2 + hA, voffA);
      G_WAIT_L(8); G_BAR; G_WAIT_L(0); G_MMA(0, 0, At, B0); G_BAR; G_SCHED;
      G_LDB(B1, 1, 1); G_STAGE(G_SB(1, 0), b3, voffB);
      G_BAR; G_WAIT_L(0); G_MMA(0, 1, At, B1); G_BAR;
      G_LDA(At, 1, 1); G_STAGE(G_SA(1, 0), a3, voffA);
      G_BAR; G_WAIT_L(0); G_MMA(1, 0, At, B0); G_BAR; G_SCHED;
      G_STAGE(G_SB(1, 1), b3 + hB, voffB);
      G_WAIT_V(6); G_BAR; G_MMA(1, 1, At, B1); G_BAR;
    }
    E(acc, cur, wr, wc, fr, fq);
    if (!has_next) break;
#pragma unroll
    for (int a = 0; a < 2; ++a)
#pragma unroll
      for (int b = 0; b < 2; ++b)
#pragma unroll
        for (int m = 0; m < 4; ++m)
#pragma unroll
          for (int n = 0; n < 2; ++n) acc[a][b][m][n] = (f32x4){0.f, 0.f, 0.f, 0.f};
    cur = nxt; cA = nA; cB = nB; ++ui;
  }
  G_WAIT_V(0);
  if (wr == 0) G_BAR;
  G_BAR;
#undef G_SA
#undef G_SB
#undef G_STAGE
#undef G_LDA
#undef G_LDB
#undef G_MMA
#undef G_WAIT_V
#undef G_WAIT_L
#undef G_BAR
#undef G_SCHED
}

template <int PH> struct Sched {
  const unsigned char* ws; int l, nM, G, c;
  __device__ __forceinline__ bool next(int i, GUnit& u) const {
    constexpr int nN = PH == 1 ? 28 : (PH == 7 ? 22 : 4);
    const long L = (long)i * G + c; if (L >= (long)nM * nN) return false;
    int pm, pn; tile_map((int)L, nM, nN, pm, pn);
    u.pm = pm; u.pn = pn;
    if (PH == 1)  { u.A = (const char*)(ws + WS_H16) + (size_t)(RB + pm * 256) * DM * 2; u.B = (const char*)(ws + WS_WIN) + ((size_t)l * INW + (size_t)pn * 256) * DM * 2; }
    if (PH == 40) { u.A = (const char*)(ws + WS_U) + ((size_t)(RB + pm * 256) * INW + C_QA) * 2; u.B = (const char*)(ws + WS_WA) + ((size_t)l * DM + (size_t)pn * 256) * DM * 2; }
    if (PH == 41) { u.A = (const char*)(ws + WS_U) + ((size_t)(RB + pm * 256) * INW + C_QB) * 2; u.B = (const char*)(ws + WS_WB) + ((size_t)l * DM + (size_t)pn * 256) * DM * 2; }
    if (PH == 42) { u.A = (const char*)(ws + WS_PD) + ((size_t)(RB + pm * 256) * DM + pn * 256) * 2; u.B = (const char*)(ws + WS_WP) + ((size_t)l * 4 + pn) * 256 * 256 * 2; }
    if (PH == 5)  { u.A = (const char*)(ws + WS_MG) + (size_t)(RB + pm * 256) * DM * 2; u.B = (const char*)(ws + WS_WO) + ((size_t)l * DM + (size_t)pn * 256) * DM * 2; }
    if (PH == 7)  { u.A = (const char*)(ws + WS_H16) + (size_t)(RB + pm * 256) * DM * 2; u.B = (const char*)(ws + WS_WUP) + ((size_t)l * NUP + (size_t)pn * 256) * DM * 2; }
    if (PH == 8)  { u.A = (const char*)(ws + WS_U) + (size_t)(RB + pm * 256) * DFF * 2; u.B = (const char*)(ws + WS_WDN) + ((size_t)l * DM + (size_t)pn * 256) * DFF * 2; }
    return true;
  }
};

__device__ __forceinline__ f16x4 to_h4(f32x4 v) { f16x4 h = {(f16)v[0], (f16)v[1], (f16)v[2], (f16)v[3]}; return h; }
__device__ __forceinline__ f32x4 to_f4(f16x4 h) { f32x4 v = {(float)h[0], (float)h[1], (float)h[2], (float)h[3]}; return v; }
struct EpiU { int dry;
  unsigned char* ws;
  __device__ __forceinline__ void operator()(const f32x4 (&acc)[2][2][4][2], const GUnit& u, int wr, int wc, int fr, int fq) const {
    if (dry) return;
    f16* U = (f16*)(ws + WS_U);
    const int row0 = RB + u.pm * BM + wr * 64 + fr, col0 = u.pn * BM + wc * 32 + 4 * fq;
#pragma unroll
    for (int ai = 0; ai < 2; ++ai)
#pragma unroll
      for (int m = 0; m < 4; ++m) { f16* rowp = U + (size_t)(row0 + ai * HALF + m * 16) * INW + col0;
#pragma unroll
        for (int bj = 0; bj < 2; ++bj)
#pragma unroll
          for (int n = 0; n < 2; ++n) *(f16x4*)(rowp + bj * HALF + n * 16) = to_h4(acc[ai][bj][m][n]); }
  }
};
template <int KIND> struct EpiGate { int dry;
  unsigned char* ws;
  __device__ __forceinline__ void operator()(const f32x4 (&acc)[2][2][4][2], const GUnit& u, int wr, int wc, int fr, int fq) const {
    if (dry) return;
    const f16* U = (const f16*)(ws + WS_U); f16* MG = (f16*)(ws + WS_MG);
    const int row0 = RB + u.pm * BM + wr * 64 + fr, col0 = u.pn * BM + wc * 32 + 4 * fq;
    constexpr int kind = KIND;
#pragma unroll
    for (int ai = 0; ai < 2; ++ai)
#pragma unroll
      for (int m = 0; m < 4; ++m) { const size_t row = (size_t)(row0 + ai * HALF + m * 16);
        const f16* gp = U + row * INW + C_UG + kind * DM + col0; f16* mp = MG + row * DM + col0;
#pragma unroll
        for (int bj = 0; bj < 2; ++bj)
#pragma unroll
          for (int n = 0; n < 2; ++n) { const f32x4 g = to_f4(*(const f16x4*)(gp + bj * HALF + n * 16)); f32x4 v = acc[ai][bj][m][n];
#pragma unroll
            for (int j = 0; j < 4; ++j) v[j] = v[j] / (1.0f + __expf(-g[j]));
            if (kind != 0) v += to_f4(*(const f16x4*)(mp + bj * HALF + n * 16));
            *(f16x4*)(mp + bj * HALF + n * 16) = to_h4(v); } }
  }
};
struct EpiResid { int dry;
  unsigned char* ws;
  __device__ __forceinline__ void operator()(const f32x4 (&acc)[2][2][4][2], const GUnit& u, int wr, int wc, int fr, int fq) const {
    if (dry) return;
    float* H = (float*)(ws + WS_H32);
    const int row0 = RB + u.pm * BM + wr * 64 + fr, col0 = u.pn * BM + wc * 32 + 4 * fq;
#pragma unroll
    for (int ai = 0; ai < 2; ++ai)
#pragma unroll
      for (int m = 0; m < 4; ++m) { float* rowp = H + (size_t)(row0 + ai * HALF + m * 16) * DM + col0;
#pragma unroll
        for (int bj = 0; bj < 2; ++bj)
#pragma unroll
          for (int n = 0; n < 2; ++n) { const f32x4 o = *(const f32x4*)(rowp + bj * HALF + n * 16); *(f32x4*)(rowp + bj * HALF + n * 16) = o * ALPHA + acc[ai][bj][m][n]; } }
  }
};
struct EpiSwiglu { int dry;
  unsigned char* ws;
  __device__ __forceinline__ void operator()(const f32x4 (&acc)[2][2][4][2], const GUnit& u, int wr, int wc, int fr, int fq) const {
    if (dry) return;
    f16* HID = (f16*)(ws + WS_U);
    const int row0 = RB + u.pm * BM + wr * 64 + fr, col0 = u.pn * HALF + wc * 32 + 4 * fq;
#pragma unroll
    for (int ai = 0; ai < 2; ++ai)
#pragma unroll
      for (int m = 0; m < 4; ++m) { f16* rowp = HID + (size_t)(row0 + ai * HALF + m * 16) * DFF + col0;
#pragma unroll
        for (int n = 0; n < 2; ++n) { const f32x4 g = acc[ai][0][m][n], up = acc[ai][1][m][n]; f32x4 v;
#pragma unroll
          for (int j = 0; j < 4; ++j) v[j] = g[j] / (1.0f + __expf(-g[j])) * up[j];
          *(f16x4*)(rowp + n * 16) = to_h4(v); } }
  }
};

__device__ __forceinline__ void slab_partial(const f16* __restrict__ A, int lda, const f16* __restrict__ B, int ldb, int kbeg, int kend, int fr, int fq, f32x4 (&acc)[4]) {
  for (int k = kbeg; k < kend; k += 32) {
    const f16x8 w = *(const f16x8*)(B + (size_t)fr * ldb + k + fq * 8);
#pragma unroll
    for (int mb = 0; mb < 4; ++mb) { const f16x8 av = *(const f16x8*)(A + (size_t)(mb * 16 + fr) * lda + k + fq * 8);
      acc[mb] = __builtin_amdgcn_mfma_f32_16x16x32_f16(w, av, acc[mb], 0, 0, 0); }
  }
}
__device__ __forceinline__ void slab_reduce(const f32x4 (&acc)[4], float* red, int tid, float& v0, float& v1) {
  const int wid = tid >> 6, lane = tid & 63;
  __syncthreads();
#pragma unroll
  for (int mb = 0; mb < 4; ++mb) *(f32x4*)(red + ((wid * 4 + mb) * 64 + lane) * 4) = acc[mb];
  __syncthreads();
  float v[2];
#pragma unroll
  for (int i = 0; i < 2; ++i) { const int e = tid + 512 * i, row = e >> 4, col = e & 15, mb = row >> 4, fr = row & 15, fq = col >> 2, j = col & 3; float s = 0.f;
#pragma unroll
    for (int w = 0; w < 8; ++w) s += red[((w * 4 + mb) * 64 + fq * 16 + fr) * 4 + j];
    v[i] = s; }
  v0 = v[0]; v1 = v[1];
}
__device__ __forceinline__ void slab_full(const f16* A, int lda, const f16* B, int ldb, int K, float* red, int tid, float& v0, float& v1) {
  const int wid = tid >> 6, lane = tid & 63, fr = lane & 15, fq = lane >> 4;
  f32x4 acc[4];
#pragma unroll
  for (int mb = 0; mb < 4; ++mb) acc[mb] = (f32x4){0.f, 0.f, 0.f, 0.f};
  const int ks = K >> 3;
  slab_partial(A, lda, B, ldb, wid * ks, wid * ks + ks, fr, fq, acc);
  slab_reduce(acc, red, tid, v0, v1);
}
template <int PH>
__device__ __forceinline__ void meta_gemm(const Args& a, int l, float* red, int swid) {
  const int tid = opaque_tid(swid);
  unsigned char* ws = a.ws;
  f16* U = (f16*)(ws + WS_U); f16* MG = (f16*)(ws + WS_MG); float* H32 = (float*)(ws + WS_H32); const f16* H16 = (const f16*)(ws + WS_H16); const f16* PD = (const f16*)(ws + WS_PD);
  constexpr int NSLAB = PH == 1 ? INW / 16 : (PH == 7 ? DFF / 16 : DM / 16);
  for (int sl = blockIdx.x; sl < NSLAB; sl += gridDim.x) {
    const int n0 = sl * 16;
    float v[2], w[2], x[2];
    if (PH == 1) slab_full(H16, DM, (const f16*)(ws + WS_WIN) + ((size_t)l * INW + n0) * DM, DM, DM, red, tid, v[0], v[1]);
    if (PH == 4) {
      slab_full(U + C_QA, INW, (const f16*)(ws + WS_WA) + ((size_t)l * DM + n0) * DM, DM, DM, red, tid, v[0], v[1]);
      slab_full(U + C_QB, INW, (const f16*)(ws + WS_WB) + ((size_t)l * DM + n0) * DM, DM, DM, red, tid, w[0], w[1]);
      const int g = n0 >> 8;
      slab_full(PD + g * 256, DM, (const f16*)(ws + WS_WP) + ((size_t)l * 4 + g) * 256 * 256 + (size_t)(n0 & 255) * 256, 256, 256, red, tid, x[0], x[1]);
    }
    if (PH == 5) slab_full(MG, DM, (const f16*)(ws + WS_WO) + ((size_t)l * DM + n0) * DM, DM, DM, red, tid, v[0], v[1]);
    if (PH == 7) { const int p = n0 >> 7, j0 = n0 & 127;
      const f16* Bg = (const f16*)(ws + WS_WUP) + ((size_t)l * NUP + p * 256 + j0) * DM;
      slab_full(H16, DM, Bg, DM, DM, red, tid, v[0], v[1]);
      slab_full(H16, DM, Bg + (size_t)128 * DM, DM, DM, red, tid, w[0], w[1]); }
    if (PH == 8) slab_full(U, DFF, (const f16*)(ws + WS_WDN) + ((size_t)l * DM + n0) * DFF, DFF, DFF, red, tid, v[0], v[1]);
#pragma unroll
    for (int i = 0; i < 2; ++i) { const int e = tid + 512 * i, row = e >> 4, col = n0 + (e & 15);
      if (PH == 1) U[(size_t)row * INW + col] = (f16)v[i];
      if (PH == 4) { const f16* gp = U + (size_t)row * INW + C_UG + col;
        const float g0 = (float)gp[0], g1 = (float)gp[DM], g2 = (float)gp[2 * DM];
        MG[(size_t)row * DM + col] = (f16)(v[i] / (1.0f + __expf(-g0)) + w[i] / (1.0f + __expf(-g1)) + x[i] / (1.0f + __expf(-g2))); }
      if (PH == 5 || PH == 8) { float* hp = H32 + (size_t)row * DM + col; *hp = *hp * ALPHA + v[i]; }
      if (PH == 7) ((f16*)(ws + WS_U))[(size_t)row * DFF + col] = (f16)(v[i] / (1.0f + __expf(-v[i])) * w[i]); }
  }
  __syncthreads();
}

__device__ __forceinline__ float wave_sum(float s) {
#pragma unroll
  for (int o = 32; o >= 1; o >>= 1) s += __shfl_xor(s, o);
  return s;
}
__device__ __forceinline__ void sincos_turns(float ang, float& sn, float& cs) {
  const double t = (double)ang * 0.15915494309189533577;
  const float fr = (float)(t - floor(t));
  sn = __builtin_amdgcn_sinf(fr); cs = __builtin_amdgcn_cosf(fr);
}
__device__ __forceinline__ void phase_prep(const Args& a, const Round& R, int l, int dry, int swid) {
  const int tid_ = opaque_tid(swid); const int wid = tid_ >> 6, lane = tid_ & 63;
  f16* U = (f16*)(a.ws + WS_U); f16* PD = (f16*)(a.ws + WS_PD);
  const int L = R.S + 16, ntok = R.nseq * L;
  const int iA = lane & 31, secA = lane >> 5;
  const int dA1 = secA * 64 + iA, dA2 = dA1 + 32;
  const int dB1 = lane, dB2 = lane + 64;
  const float invA = (float)exp2(-(double)(2 * iA) / 64.0 * 13.287712379549449);
  const float invB = (float)exp2(-(double)(2 * lane) / 128.0 * 13.287712379549449);
  const float gq1 = a.qg[l * 128 + dA1], gq2 = a.qg[l * 128 + dA2], gk1 = a.kg[l * 128 + dA1], gk2 = a.kg[l * 128 + dA2];
  const int pg = lane >> 4, win = 2 << pg, c0 = lane * 16;
  for (int tok = blockIdx.x * 8 + wid; tok < ntok; tok += gridDim.x * 8) {
    const int s = tok / L, t = tok - s * L;
    const int mb_ = 16 * s, rb_ = RB + R.S * s - 16;
    const int row = t < 16 ? mb_ + t : rb_ + t;
    f16* up = U + (size_t)row * INW;
    int prow, pcol;
    if (t < 16) { prow = -1; pcol = t; } else { const int i = t - 16; prow = i >> 6; pcol = i & 63; }
    float snA, csA, snB, csB;
    sincos_turns((float)(secA ? pcol : prow) * invA, snA, csA);
    sincos_turns((float)t * invB, snB, csB);
#pragma unroll
    for (int h = 0; h < 10; ++h) {
      f16* p = up + (h < 8 ? C_QA + h * 128 : C_KA + (h - 8) * 128);
      float x1 = (float)p[dA1], x2 = (float)p[dA2];
      const float ss = wave_sum(x1 * x1 + x2 * x2);
      const float rs = 1.0f / sqrtf(ss * (1.0f / 128.0f) + 1e-6f);
      x1 = x1 * rs * (h < 8 ? gq1 : gk1); x2 = x2 * rs * (h < 8 ? gq2 : gk2);
      if (!dry) { p[dA1] = (f16)(x1 * csA - x2 * snA); p[dA2] = (f16)(x1 * snA + x2 * csA); }
    }
#pragma unroll
    for (int h = 0; h < 10; ++h) {
      f16* p = up + (h < 8 ? C_QB + h * 128 : C_KB + (h - 8) * 128);
      const float x1 = (float)p[dB1], x2 = (float)p[dB2];
      if (!dry) { p[dB1] = (f16)(x1 * csB - x2 * snB); p[dB2] = (f16)(x1 * snB + x2 * csB); }
    }
    {
      int lo = t - win / 2; int hi = lo + win; lo = lo < 0 ? 0 : lo; hi = hi > L ? L : hi;
      float acc[16];
#pragma unroll
      for (int j = 0; j < 16; ++j) acc[j] = 0.f;
      for (int tt = lo; tt < hi; ++tt) {
        const f16* q = U + (size_t)(tt < 16 ? mb_ + tt : rb_ + tt) * INW + C_UC + c0;
        const f16x8 v0 = *(const f16x8*)q, v1 = *(const f16x8*)(q + 8);
#pragma unroll
        for (int j = 0; j < 8; ++j) { acc[j] += (float)v0[j]; acc[8 + j] += (float)v1[j]; }
      }
      const float rc = 1.0f / (float)(hi - lo);
      const f16x8 s0 = *(const f16x8*)(up + C_UC + c0), s1 = *(const f16x8*)(up + C_UC + c0 + 8);
      f16x8 o0, o1;
#pragma unroll
      for (int j = 0; j < 8; ++j) { o0[j] = (f16)(acc[j] * rc - (float)s0[j]); o1[j] = (f16)(acc[8 + j] * rc - (float)s1[j]); }
      if (!dry) { *(f16x8*)(PD + (size_t)row * DM + c0) = o0; *(f16x8*)(PD + (size_t)row * DM + c0 + 8) = o1; }
    }
  }
}

constexpr int AD = 128, KVBLK = 64, LDQ = INW;
constexpr float ASCALE = 0.088388347648318440f;
constexpr float ATHR = 8.f;
constexpr int SHM_V = KVBLK * AD * 2, SHM_K = KVBLK * AD * 2;
typedef short s16x4 __attribute__((ext_vector_type(4)));
#define KSWZ(row, colB) ((row) * 256 + ((colB) ^ (((row) & 7) << 4)))
#define SBAR() __builtin_amdgcn_sched_barrier(0)
__device__ __forceinline__ int crow(int r, int hi) { return (r & 3) + 8 * (r >> 2) + 4 * hi; }
__device__ __forceinline__ unsigned cvtpk(float lo, float hi) { f16x2 v = {(f16)lo, (f16)hi}; return __builtin_bit_cast(unsigned, v); }

__device__ __forceinline__ void partialSM(f32x16& p0, f32x16& p1, float& m_reg, float& mn, float& alpha) {
  constexpr float C = ASCALE * 1.4426950408889634f;
  float pmax = p0[0];
#pragma unroll
  for (int r = 1; r < 16; ++r) pmax = fmaxf(pmax, p0[r]);
#pragma unroll
  for (int r = 0; r < 16; ++r) pmax = fmaxf(pmax, p1[r]);
  { auto rr = __builtin_amdgcn_permlane32_swap(__float_as_uint(pmax), __float_as_uint(pmax), false, false);
    pmax = fmaxf(__uint_as_float(rr[0]), __uint_as_float(rr[1])); }
  if (__builtin_expect(__all(pmax - m_reg <= ATHR / ASCALE), 1)) { mn = m_reg; alpha = 1.f; }
  else { mn = fmaxf(m_reg, pmax); alpha = __builtin_amdgcn_exp2f((m_reg - mn) * C); m_reg = mn; }
  const float mnC = -mn * C;
#pragma unroll
  for (int r = 0; r < 16; ++r) p0[r] = fmaf(p0[r], C, mnC);
#pragma unroll
  for (int r = 0; r < 16; ++r) p1[r] = fmaf(p1[r], C, mnC);
#pragma unroll
  for (int r = 0; r < 16; ++r) p0[r] = __builtin_amdgcn_exp2f(p0[r]);
}
__device__ __forceinline__ void finishSM(f32x16& p0, f32x16& p1, float alpha, float& l_reg, f16x8& pa0, f16x8& pa1, f16x8& pa2, f16x8& pa3) {
#pragma unroll
  for (int r = 0; r < 16; ++r) p1[r] = __builtin_amdgcn_exp2f(p1[r]);
  float ps = 0;
#pragma unroll
  for (int r = 0; r < 16; ++r) ps += p0[r];
#pragma unroll
  for (int r = 0; r < 16; ++r) ps += p1[r];
  { auto rr = __builtin_amdgcn_permlane32_swap(__float_as_uint(ps), __float_as_uint(ps), false, false);
    ps = __uint_as_float(rr[0]) + __uint_as_float(rr[1]); }
  l_reg = l_reg * alpha + ps;
#define PK4(P, BASE, OUT) do { unsigned a0 = cvtpk(P[BASE + 0], P[BASE + 1]), a1 = cvtpk(P[BASE + 2], P[BASE + 3]);   \
    unsigned b0 = cvtpk(P[BASE + 4], P[BASE + 5]), b1 = cvtpk(P[BASE + 6], P[BASE + 7]);                              \
    auto r0 = __builtin_amdgcn_permlane32_swap(a0, b0, false, false); auto r1 = __builtin_amdgcn_permlane32_swap(a1, b1, false, false); \
    u32x4 w = {r0[0], r1[0], r0[1], r1[1]}; OUT = __builtin_bit_cast(f16x8, w); } while (0)
  PK4(p0, 0, pa0); PK4(p0, 8, pa1); PK4(p1, 0, pa2); PK4(p1, 8, pa3);
#undef PK4
}
__device__ __forceinline__ void qkt(f32x16& p0, f32x16& p1, const char* Ks, const f16x8* qr, int r32, int hi) {
  p0 = f32x16{}; p1 = f32x16{};
#pragma unroll
  for (int d0 = 0; d0 < 8; ++d0) { const int cb = (d0 * 16 + hi * 8) * 2;
    const f16x8 b0 = *reinterpret_cast<const f16x8*>(Ks + KSWZ(r32, cb));
    const f16x8 b1 = *reinterpret_cast<const f16x8*>(Ks + KSWZ(32 + r32, cb));
    p0 = __builtin_amdgcn_mfma_f32_32x32x16_f16(b0, qr[d0], p0, 0, 0, 0);
    p1 = __builtin_amdgcn_mfma_f32_32x32x16_f16(b1, qr[d0], p1, 0, 0, 0); }
}
__device__ __forceinline__ void mask_tile(f32x16& p0, f32x16& p1, int ka, int kb, int hi) {
  const int a2 = ka - 4 * hi; const unsigned span = (unsigned)(kb - ka);
#pragma unroll
  for (int r = 0; r < 16; ++r) { const int c = (r & 3) + 8 * (r >> 2);
    p0[r] = ((unsigned)(c - a2) <= span && kb >= ka) ? p0[r] : -1e30f;
    p1[r] = ((unsigned)(c + 32 - a2) <= span && kb >= ka) ? p1[r] : -1e30f; }
}
__device__ __forceinline__ int v_st(int k, int c) { const int kk = (k & ~0xC) | ((k & 4) << 1) | ((k & 8) >> 1); return ((kk >> 3) * 4 + (c >> 5)) * 512 + ((kk & 7) * 32 + (c & 31)) * 2; }
__device__ __forceinline__ int v_rd_base(int lane) { return ((lane & 3) << 3) | (((lane >> 2) & 3) << 6) | (((lane >> 4) & 1) << 5) | (((lane >> 5) & 1) << 8); }
constexpr int v_rd_off(int d0, int ks, int half) { return d0 * 512 + ks * 4096 + half * 2048; }
template <int OFF> __device__ __forceinline__ s16x4 tr_read(int vb) {
  s16x4 r; asm volatile("ds_read_b64_tr_b16 %0, %1 offset:%2" : "=&v"(r) : "v"(vb), "i"(OFF) : "memory"); return r;
}
template <int D0> __device__ __forceinline__ void pv_one(f32x16& od, int vb, f16x8 pa0, f16x8 pa1, f16x8 pa2, f16x8 pa3) {
  const s16x4 l0 = tr_read<v_rd_off(D0, 0, 0)>(vb), h0 = tr_read<v_rd_off(D0, 0, 1)>(vb), l1 = tr_read<v_rd_off(D0, 1, 0)>(vb), h1 = tr_read<v_rd_off(D0, 1, 1)>(vb);
  const s16x4 l2 = tr_read<v_rd_off(D0, 2, 0)>(vb), h2 = tr_read<v_rd_off(D0, 2, 1)>(vb), l3 = tr_read<v_rd_off(D0, 3, 0)>(vb), h3 = tr_read<v_rd_off(D0, 3, 1)>(vb);
  asm volatile("s_waitcnt lgkmcnt(0)" ::: "memory"); SBAR();
  typedef short s16x8 __attribute__((ext_vector_type(8)));
#define PK(L, H) __builtin_bit_cast(f16x8, (s16x8){L[0], L[1], L[2], L[3], H[0], H[1], H[2], H[3]})
  od = __builtin_amdgcn_mfma_f32_32x32x16_f16(pa0, PK(l0, h0), od, 0, 0, 0);
  od = __builtin_amdgcn_mfma_f32_32x32x16_f16(pa1, PK(l1, h1), od, 0, 0, 0);
  od = __builtin_amdgcn_mfma_f32_32x32x16_f16(pa2, PK(l2, h2), od, 0, 0, 0);
  od = __builtin_amdgcn_mfma_f32_32x32x16_f16(pa3, PK(l3, h3), od, 0, 0, 0);
#undef PK
}
__device__ __forceinline__ void pv_d0(f32x16* o, int vb, f16x8 pa0, f16x8 pa1, f16x8 pa2, f16x8 pa3) {
  pv_one<0>(o[0], vb, pa0, pa1, pa2, pa3); pv_one<1>(o[1], vb, pa0, pa1, pa2, pa3); pv_one<2>(o[2], vb, pa0, pa1, pa2, pa3); pv_one<3>(o[3], vb, pa0, pa1, pa2, pa3);
}

template <int MODE, int PART>
__device__ __forceinline__ void attn_body(const f16* Qb, const f16* __restrict__ KV, int kcol, int vcol, int NT, int tfirst, int tstart, int Tlast, int mrow, int rbase,
                                          int qoff, int wlo, int whi, int Sm1, float sink, int nvalid, float* part, char* lds, int swid) {
  const int tid = opaque_tid(swid), wid = tid >> 6, lane = tid & 63, r32 = lane & 31, hi = lane >> 5;
  char* V_lds = lds; char* K_lds = lds + 2 * SHM_V;
  float* wsf = (float*)(lds + 2 * SHM_V + 2 * SHM_K) + wid * 64; float* li_l = wsf; float* al_l = wsf + 32;
  float m_reg = -1e30f, l_reg = 0; f32x16 o[4] = {}; f16x8 qr[8];
  const f16* Qw = Qb + (size_t)(wid * 32 + r32) * LDQ + hi * 8;
#pragma unroll
  for (int d0 = 0; d0 < 8; ++d0) qr[d0] = *reinterpret_cast<const f16x8*>(Qw + d0 * 16);
  const int sr = tid >> 4, sc = (tid & 15) * 8, vst0 = v_st(sr, sc), vst1 = v_st(32 + sr, sc);
  const int vb0 = (int)(uintptr_t)V_lds + v_rd_base(lane);
  const f16* Kh = KV + kcol; const f16* Vh = KV + vcol;
  struct { f16x8 vs0, vs1, ks0, ks1; } sr_[2];
#define TIDX(j) ((j) == 0 ? tfirst : (tstart + (j)))
#define KROW(j) ({ int _t = TIDX(j); _t = _t >= Tlast ? Tlast - 1 : _t; (_t <= 0) ? mrow : rbase + (_t - 1) * KVBLK; })
#define SLOAD(i, j) do { const int _k0 = KROW(j); sr_[i].vs0 = *(const f16x8*)&Vh[(size_t)(_k0 + sr) * LDQ + sc]; sr_[i].vs1 = *(const f16x8*)&Vh[(size_t)(_k0 + 32 + sr) * LDQ + sc]; \
    sr_[i].ks0 = *(const f16x8*)&Kh[(size_t)(_k0 + sr) * LDQ + sc]; sr_[i].ks1 = *(const f16x8*)&Kh[(size_t)(_k0 + 32 + sr) * LDQ + sc]; } while (0)
#define SWRITE(b, i) do { *(f16x8*)(V_lds + (b) * SHM_V + vst0) = sr_[i].vs0;          \
    *(f16x8*)(V_lds + (b) * SHM_V + vst1) = sr_[i].vs1; const int kc = sc * 2;               \
    *(f16x8*)(K_lds + (b) * SHM_K + KSWZ(sr, kc)) = sr_[i].ks0;                       \
    *(f16x8*)(K_lds + (b) * SHM_K + KSWZ(32 + sr, kc)) = sr_[i].ks1; } while (0)
#define SWAIT() asm volatile("s_waitcnt vmcnt(4)" ::: "memory")
#define RESC(a) do { if (__any((a) < 1.f)) { if (hi == 0) al_l[r32] = (a); asm volatile("s_waitcnt lgkmcnt(0)" ::: "memory"); \
    _Pragma("unroll") for (int d = 0; d < 4; ++d) _Pragma("unroll") for (int r = 0; r < 16; ++r) o[d][r] *= al_l[crow(r, hi)]; } } while (0)
#define MASKJ(P0, P1, j) do { if (MODE == 1) { const int _kb = (TIDX(j) - 1) * KVBLK; const int _qi = qoff + wid * 32 + r32; int _lo = _qi - wlo; _lo = _lo < 0 ? 0 : _lo; int _hi = _qi + whi; _hi = _hi > Sm1 ? Sm1 : _hi; \
    mask_tile(P0, P1, _lo - _kb, _hi - _kb, hi); } } while (0)
  f32x16 pA0, pA1, pB0, pB1; float mnA, mnB, alA, alB; f16x8 pa0, pa1, pa2, pa3;
  constexpr int SE = 0, SO = 1;
  SLOAD(SE, 0); asm volatile("s_waitcnt vmcnt(0)" ::: "memory"); SWRITE(0, SE); __syncthreads();
  qkt(pA0, pA1, K_lds, qr, r32, hi); if (tfirst == 0) mask_tile(pA0, pA1, 0, 15, hi); partialSM(pA0, pA1, m_reg, mnA, alA);
  SLOAD(SO, 1); if (2 < NT) SLOAD(SE, 2);
  SWAIT(); SWRITE(1, SO); __syncthreads();
  for (int j = 1; j + 1 < NT; j += 2) {
    SBAR(); qkt(pB0, pB1, K_lds + SHM_K, qr, r32, hi); MASKJ(pB0, pB1, j);
    finishSM(pA0, pA1, alA, l_reg, pa0, pa1, pa2, pa3); SBAR();
    SLOAD(SO, j + 2); SBAR();
    pv_d0(o, vb0, pa0, pa1, pa2, pa3); partialSM(pB0, pB1, m_reg, mnB, alB);
    __syncthreads(); SWAIT(); SWRITE(0, SE);
    RESC(alB); __syncthreads();
    SBAR(); qkt(pA0, pA1, K_lds, qr, r32, hi); MASKJ(pA0, pA1, j + 1);
    finishSM(pB0, pB1, alB, l_reg, pa0, pa1, pa2, pa3); SBAR();
    if (j + 3 < NT) SLOAD(SE, j + 3); SBAR();
    pv_d0(o, vb0 + SHM_V, pa0, pa1, pa2, pa3); partialSM(pA0, pA1, m_reg, mnA, alA);
    __syncthreads(); SWAIT(); SWRITE(1, SO);
    RESC(alA); __syncthreads();
  }
  SBAR(); qkt(pB0, pB1, K_lds + SHM_K, qr, r32, hi);
  if (MODE == 0) { if (tstart + NT - 1 == Tlast) mask_tile(pB0, pB1, 1, 0, hi); } else MASKJ(pB0, pB1, NT - 1);
  finishSM(pA0, pA1, alA, l_reg, pa0, pa1, pa2, pa3); SBAR();
  pv_d0(o, vb0, pa0, pa1, pa2, pa3); partialSM(pB0, pB1, m_reg, mnB, alB);
  __syncthreads(); RESC(alB);
  finishSM(pB0, pB1, alB, l_reg, pa0, pa1, pa2, pa3); SBAR();
  pv_d0(o, vb0 + SHM_V, pa0, pa1, pa2, pa3);
  if (MODE == 1) l_reg += __builtin_amdgcn_exp2f(sink * 1.4426950408889634f - m_reg * (ASCALE * 1.4426950408889634f));
  if (hi == 0) li_l[r32] = l_reg; asm volatile("s_waitcnt lgkmcnt(0)" ::: "memory");
  float rli[16];
#pragma unroll
  for (int r = 0; r < 16; ++r) rli[r] = __builtin_amdgcn_rcpf(li_l[crow(r, hi)]);
  if (PART == 0) {
    f16* Ow = const_cast<f16*>(Qb) + (size_t)(wid * 32) * LDQ;
#pragma unroll
    for (int r = 0; r < 16; ++r) { const int orow = crow(r, hi);
      if (wid * 32 + orow < nvalid) {
#pragma unroll
        for (int d0 = 0; d0 < 4; ++d0) Ow[(size_t)orow * LDQ + d0 * 32 + r32] = (f16)(o[d0][r] * rli[r]); } }
  } else {
#pragma unroll
    for (int r = 0; r < 16; ++r) { const int orow = crow(r, hi);
      if (wid * 32 + orow < 16) {
#pragma unroll
        for (int d0 = 0; d0 < 4; ++d0) part[orow * 128 + d0 * 32 + r32] = o[d0][r] * rli[r]; } }
    if (tid < 16) { part[2048 + tid] = m_reg; part[2064 + tid] = l_reg; }
  }
  __syncthreads();
#undef SLOAD
#undef SWRITE
#undef SWAIT
#undef RESC
#undef MASKJ
#undef TIDX
#undef KROW
}

constexpr int PART_FLOATS = 2080;
#ifndef SPLITKV
#define SPLITKV 1
#endif
constexpr int CHUNK_T = 6;
__device__ __forceinline__ void phase_attn(const Args& a, const Round& R, int l, unsigned* counter, char* lds, int dry, int swid) {
  f16* U = (f16*)(a.ws + WS_U);
  float* PART = (float*)(a.ws + WS_PART);
  const int NQB = R.S / 256, per_seq = 8 * NQB;
  const int Tlast = R.S / 64 + 1, nchunk = (Tlast + 1) / CHUNK_T;
  const int nreal = R.nseq * per_seq, nmeta = (l == 0) ? R.nseq * 8 : 0, nmc = SPLITKV ? nmeta * nchunk : nmeta;
  const int total = nmc + 2 * nreal + nmeta;
  const int tid_ = opaque_tid(swid);
  unsigned* slot = (unsigned*)(lds + 131072);
  for (;;) {
    if (tid_ == 0) *slot = atomicAdd(counter, 1u);
    __syncthreads();
    const int idx = (int)*slot;
    __syncthreads();
    if (idx >= total) break;
    if (!SPLITKV && idx < nmc) {
      const int s = idx >> 3, head = idx & 7;
      const f16* Q = U + (size_t)(16 * s) * INW + C_QA + head * 128;
      attn_body<0, 0>(Q, U, C_KA + (head >> 2) * 128, C_VA + (head >> 2) * 128, Tlast + 1, 0, 0, Tlast, 16 * s, RB + R.S * s, 0, 0, 0, 0, 0.f, dry ? 0 : 16, nullptr, lds, swid);
      continue;
    }
    if (SPLITKV && idx < nmc) {
      const int u = idx / nchunk, c = idx - u * nchunk, s = u >> 3, head = u & 7;
      const f16* Q = U + (size_t)(16 * s) * INW + C_QA + head * 128;
      attn_body<0, 1>(Q, U, C_KA + (head >> 2) * 128, C_VA + (head >> 2) * 128, CHUNK_T, c * CHUNK_T, c * CHUNK_T, Tlast, 16 * s, RB + R.S * s,
                      0, 0, 0, 0, 0.f, 0, PART + (size_t)idx * PART_FLOATS, lds, swid);
      continue;
    }
    int k = idx - nmc;
    if (k < nreal) {
      const int s = k / per_seq, rem = k - s * per_seq, head = rem / NQB, qb = rem - head * NQB;
      const f16* Q = U + (size_t)(RB + R.S * s + qb * 256) * INW + C_QA + head * 128;
      attn_body<0, 0>(Q, U, C_KA + (head >> 2) * 128, C_VA + (head >> 2) * 128, Tlast + 1, 0, 0, Tlast, 16 * s, RB + R.S * s, 0, 0, 0, 0, 0.f, dry ? 0 : 256, nullptr, lds, swid);
      continue;
    }
    k -= nreal;
    int meta, s, head, qb;
    if (k < nreal) { meta = 0; s = k / per_seq; const int rem = k - s * per_seq; head = rem / NQB; qb = rem - head * NQB; }
    else { meta = 1; k -= nreal; s = k >> 3; head = k & 7; qb = 0; }
    const f16* Q = U + (size_t)(meta ? 16 * s : RB + R.S * s + qb * 256) * INW + C_QB + head * 128;
    const float sink = a.sink[l * 8 + head];
    attn_body<1, 0>(Q, U, C_KB + (head >> 2) * 128, C_VB + (head >> 2) * 128, meta ? 4 : 10, 0, meta ? 0 : qb * 4 - 2, Tlast, 16 * s, RB + R.S * s,
                    qb * 256, meta ? (1 << 24) : 128, meta ? 112 : 128, R.S - 1, sink, dry ? 0 : (meta ? 16 : 256), nullptr, lds, swid);
  }
}
__device__ __forceinline__ void phase_combine(const Args& a, const Round& R, int swid) {
  f16* U = (f16*)(a.ws + WS_U); const float* PART = (const float*)(a.ws + WS_PART);
  const int Tlast = R.S / 64 + 1, nchunk = (Tlast + 1) / CHUNK_T;
  const int tid_ = opaque_tid(swid); const int wid = tid_ >> 6, lane = tid_ & 63;
  constexpr float C = ASCALE * 1.4426950408889634f;
  for (int it = blockIdx.x * 8 + wid; it < R.nseq * 8 * 16; it += gridDim.x * 8) {
    const int u = it >> 4, m = it & 15, s = u >> 3, head = u & 7;
    const float* p0 = PART + (size_t)u * nchunk * PART_FLOATS;
    float mx = -1e30f;
    for (int c = 0; c < nchunk; ++c) mx = fmaxf(mx, p0[(size_t)c * PART_FLOATS + 2048 + m]);
    float wsum = 0.f, o0 = 0.f, o1 = 0.f;
    for (int c = 0; c < nchunk; ++c) { const float* p = p0 + (size_t)c * PART_FLOATS;
      const float w = p[2064 + m] * __builtin_amdgcn_exp2f((p[2048 + m] - mx) * C);
      wsum += w; o0 += w * p[m * 128 + lane]; o1 += w * p[m * 128 + 64 + lane]; }
    const float rw = 1.0f / wsum;
    f16* dst = U + (size_t)(16 * s + m) * INW + C_QA + head * 128;
    dst[lane] = (f16)(o0 * rw); dst[64 + lane] = (f16)(o1 * rw);
  }
}

#ifndef PROBE
#define PROBE 0
#endif
#define RELAUNDER() do { } while (0)
__global__ void __launch_bounds__(NTHR, 2) mega(Args a) {
  extern __shared__ __attribute__((aligned(16))) unsigned char lds[];
  cg::grid_group grid = cg::this_grid();
  const int swid = __builtin_amdgcn_readfirstlane((int)(threadIdx.x >> 6));
  volatile LAS unsigned* bst = (volatile LAS unsigned*)((LAS unsigned char*)lds + 131072 + 64);
  if (threadIdx.x < 2) bst[threadIdx.x] = 0u;
  __syncthreads();
  const XcdBarrier xbar = xcd_barrier_post((unsigned*)(a.ws + WS_BAR), bst, (int)threadIdx.x);
  phase_weights(a, (float*)lds, swid);
  { const Round R0 = get_round(0); phase_rows(a, R0, 0, nullptr, nullptr, 0, swid); }
  grid.sync();
  LAS unsigned char* ldsl = (LAS unsigned char*)lds;
  for (int r = 0; r < 4; ++r) {
    const Round R = get_round(r);
    const int nM = 64;
    for (int l = 0; l < 2; ++l) {
      RELAUNDER();
      meta_gemm<1>(a, l, (float*)lds, swid);
      { Sched<1> S{a.ws, l, nM, (int)gridDim.x, (int)blockIdx.x}; EpiU E{0, a.ws}; gemm_phase<DM * 2, DM * 2, 16>(ldsl, S, E, swid);
        if (PROBE == 1) gemm_phase<DM * 2, DM * 2, 16>(ldsl, S, E, swid); }
      xcd_barrier(xbar, swid); RELAUNDER();
      phase_prep(a, R, l, 0, swid);
      if (PROBE == 3) phase_prep(a, R, l, a.dry_on, swid);
      xcd_barrier(xbar, swid); RELAUNDER();
      phase_attn(a, R, l, (unsigned*)(a.ws + WS_CTL) + (r * 2 + l) * 64, (char*)lds, 0, swid);
      if (PROBE == 2) phase_attn(a, R, l, (unsigned*)(a.ws + WS_CTL) + (r * 2 + l) * 64 + 32, (char*)lds, a.dry_on, swid);
      xcd_barrier(xbar, swid); RELAUNDER();
      if (SPLITKV && l == 0) { phase_combine(a, R, swid); xcd_barrier(xbar, swid); RELAUNDER(); }
      meta_gemm<4>(a, l, (float*)lds, swid);
      for (int rep = 0; rep < (PROBE == 1 ? 2 : 1); ++rep) {
      { Sched<40> S{a.ws, l, nM, (int)gridDim.x, (int)blockIdx.x}; EpiGate<0> E{0, a.ws}; gemm_phase<INW * 2, DM * 2, 16>(ldsl, S, E, swid); }
      { Sched<41> S{a.ws, l, nM, (int)gridDim.x, (int)blockIdx.x}; EpiGate<1> E{0, a.ws}; gemm_phase<INW * 2, DM * 2, 16>(ldsl, S, E, swid); }
      { Sched<42> S{a.ws, l, nM, (int)gridDim.x, (int)blockIdx.x}; EpiGate<2> E{0, a.ws}; gemm_phase<DM * 2, 256 * 2, 4>(ldsl, S, E, swid); }
      }
      xcd_barrier(xbar, swid); RELAUNDER();
      meta_gemm<5>(a, l, (float*)lds, swid);
      { Sched<5> S{a.ws, l, nM, (int)gridDim.x, (int)blockIdx.x}; EpiResid E{0, a.ws}; gemm_phase<DM * 2, DM * 2, 16>(ldsl, S, E, swid);
        if (PROBE == 1) { E.dry = a.dry_on; gemm_phase<DM * 2, DM * 2, 16>(ldsl, S, E, swid); } }
      xcd_barrier(xbar, swid); RELAUNDER();
      phase_rows(a, R, 1, a.ln1g + l * DM, a.ln1b + l * DM, -1, swid);
      if (PROBE == 3) phase_rows(a, R, 1, a.ln1g + l * DM, a.ln1b + l * DM, -1, swid, a.dry_on);
      xcd_barrier(xbar, swid); RELAUNDER();
      meta_gemm<7>(a, l, (float*)lds, swid);
      { Sched<7> S{a.ws, l, nM, (int)gridDim.x, (int)blockIdx.x}; EpiSwiglu E{0, a.ws}; gemm_phase<DM * 2, DM * 2, 16>(ldsl, S, E, swid);
        if (PROBE == 1) gemm_phase<DM * 2, DM * 2, 16>(ldsl, S, E, swid); }
      xcd_barrier(xbar, swid); RELAUNDER();
      meta_gemm<8>(a, l, (float*)lds, swid);
      { Sched<8> S{a.ws, l, nM, (int)gridDim.x, (int)blockIdx.x}; EpiResid E{0, a.ws}; gemm_phase<DFF * 2, DFF * 2, 44>(ldsl, S, E, swid);
        if (PROBE == 1) { E.dry = a.dry_on; gemm_phase<DFF * 2, DFF * 2, 44>(ldsl, S, E, swid); } }
      xcd_barrier(xbar, swid); RELAUNDER();
      if (PROBE == 3) phase_rows(a, R, 1, a.ln2g + l * DM, a.ln2b + l * DM, -1, swid, a.dry_on);
      if (l == 0) phase_rows(a, R, 1, a.ln2g + l * DM, a.ln2b + l * DM, -1, swid);
      else phase_rows(a, R, 2, a.ln2g + l * DM, a.ln2b + l * DM, r < 3 ? r + 1 : -1, swid);
      xcd_barrier(xbar, swid); RELAUNDER();
    }
  }
}

extern "C" void kernel_launch(void* const* d_in, const int* in_sizes, int n_in, void* d_out, int out_size, void* d_ws, size_t ws_size, hipStream_t stream) {
  static int grid_blocks = 0;
  if (grid_blocks == 0) {
    if (n_in != 18 || ws_size < WS_END) { fprintf(stderr, "kernel_launch: n_in %d ws %zu (need %zu)\n", n_in, ws_size, (size_t)WS_END); grid_blocks = -1; return; }
    int dev = 0, cus = 0, per_cu = 0;
    hipGetDevice(&dev);
    hipDeviceGetAttribute(&cus, hipDeviceAttributeMultiprocessorCount, dev);
    if (hipFuncSetAttribute((const void*)mega, hipFuncAttributeMaxDynamicSharedMemorySize, LDS_BYTES) != hipSuccess) { fprintf(stderr, "kernel_launch: hipFuncSetAttribute failed\n"); grid_blocks = -1; return; }
    hipOccupancyMaxActiveBlocksPerMultiprocessor(&per_cu, (const void*)mega, NTHR, LDS_BYTES);
    if (per_cu < 1) { fprintf(stderr, "kernel_launch: occupancy query gave %d\n", per_cu); per_cu = 1; }
    if (per_cu > 1) per_cu = 1;
    grid_blocks = cus * per_cu;
  }
  if (grid_blocks < 0) return;
  (void)hipMemsetAsync((char*)d_ws + WS_CTL, 0, CTL_BYTES, stream);
  Args a{};
  a.x_prompt = (const float*)d_in[0]; a.x_sample = (const float*)d_in[1]; a.meta = (const float*)d_in[2]; a.w_in = (const float*)d_in[3];
  a.qg = (const float*)d_in[4]; a.kg = (const float*)d_in[5]; a.sink = (const float*)d_in[6]; a.pool_w = (const float*)d_in[7]; a.pool_scale = (const float*)d_in[8];
  a.w_a = (const float*)d_in[9]; a.w_b = (const float*)d_in[10]; a.w_out = (const float*)d_in[11]; a.ln1g = (const float*)d_in[12]; a.ln1b = (const float*)d_in[13];
  a.w_up = (const float*)d_in[14]; a.w_down = (const float*)d_in[15]; a.ln2g = (const float*)d_in[16]; a.ln2b = (const float*)d_in[17];
  a.out = (float*)d_out; a.ws = (unsigned char*)d_ws; a.dry_on = 1; a.pad = 0;
  void* args[] = {&a};
  hipError_t e = hipLaunchCooperativeKernel((const void*)mega, dim3(grid_blocks), dim3(NTHR), args, LDS_BYTES, stream);
  if (e != hipSuccess) fprintf(stderr, "cooperative launch failed: %s (grid %d)\n", hipGetErrorString(e), grid_blocks);
}
```

```cpp
#include <hip/hip_runtime.h>
#include <hip/hip_cooperative_groups.h>
#include <cstdio>
namespace cg = cooperative_groups;

#define LAS __attribute__((address_space(3)))
typedef _Float16 f16;
typedef _Float16 f16x8 __attribute__((ext_vector_type(8)));
typedef _Float16 f16x4 __attribute__((ext_vector_type(4)));
typedef _Float16 f16x2 __attribute__((ext_vector_type(2)));
typedef float f32x4 __attribute__((ext_vector_type(4)));
typedef float f32x16 __attribute__((ext_vector_type(16)));
typedef unsigned u32x4 __attribute__((ext_vector_type(4)));
typedef unsigned u32x2 __attribute__((ext_vector_type(2)));

__device__ __forceinline__ int opaque_tid(int swid) { int t = swid * 64 + (int)__builtin_amdgcn_mbcnt_hi(~0u, __builtin_amdgcn_mbcnt_lo(~0u, 0u)); asm volatile("" : "+v"(t)); return t; }

constexpr int DM = 1024, INW = 7168, DFF = 2816, NUP = 5632;
constexpr int RB = 128;
constexpr int MROWS = RB + 16384;
constexpr int C_QA = 0, C_KA = 1024, C_VA = 1280, C_QB = 1536, C_KB = 2560, C_VB = 2816, C_UC = 3072, C_UG = 4096;
constexpr float ALPHA = 1.4142135623730951f;
constexpr int NTHR = 512;

constexpr size_t WS_CTL = 0;
constexpr size_t WS_BAR = 4096;
constexpr size_t CTL_BYTES = 32768;
constexpr size_t WS_WIN = CTL_BYTES;
constexpr size_t WS_WA  = WS_WIN + (size_t)2 * INW * DM * 2;
constexpr size_t WS_WB  = WS_WA + (size_t)2 * DM * DM * 2;
constexpr size_t WS_WO  = WS_WB + (size_t)2 * DM * DM * 2;
constexpr size_t WS_WP  = WS_WO + (size_t)2 * DM * DM * 2;
constexpr size_t WS_WUP = WS_WP + (size_t)2 * 4 * 256 * 256 * 2;
constexpr size_t WS_WDN = WS_WUP + (size_t)2 * NUP * DM * 2;
constexpr size_t WS_U   = WS_WDN + (size_t)2 * DM * DFF * 2;
constexpr size_t WS_PD  = WS_U + (size_t)MROWS * INW * 2;
constexpr size_t WS_MG  = WS_PD + (size_t)MROWS * DM * 2;
constexpr size_t WS_H16 = WS_MG + (size_t)MROWS * DM * 2;
constexpr size_t WS_H32 = WS_H16 + (size_t)MROWS * DM * 2;
constexpr size_t WS_PART = WS_H32 + (size_t)MROWS * DM * 4;
constexpr size_t WS_END = WS_PART + (size_t)352 * 2080 * 4;
constexpr int LDS_BYTES = 131072 + 256;

struct Args {
  const float* x_prompt; const float* x_sample; const float* meta; const float* w_in; const float* qg; const float* kg; const float* sink;
  const float* pool_w; const float* pool_scale; const float* w_a; const float* w_b; const float* w_out; const float* ln1g; const float* ln1b;
  const float* w_up; const float* w_down; const float* ln2g; const float* ln2b;
  float* out; unsigned char* ws; int dry_on; int pad;
};

struct Round { int nseq, S, is_sample, b0; };
__device__ __forceinline__ Round get_round(int r) {
  Round R;
  if (r < 2) { R.nseq = 4; R.S = 4096; R.is_sample = 0; R.b0 = r * 4; }
  else       { R.nseq = 1; R.S = 16384; R.is_sample = 1; R.b0 = r & 1; }
  return R;
}

#define XB_TMO      128
#define XB_XCNT(j)  (256  + 64 * (j))
#define XB_XSUB(j)  (1280 + 64 * (j))
#define XB_XGEN(j)  (2304 + 64 * (j))
#define XB_TOP      3328
#define XB_TOPGEN   3392
#define XCD_BAR_WORDS 3456
#define XB_SPIN_CAP (1u << 22)
__device__ __forceinline__ unsigned xb_ld(unsigned* p)              { return __hip_atomic_load(p, __ATOMIC_RELAXED, __HIP_MEMORY_SCOPE_AGENT); }
__device__ __forceinline__ unsigned xb_add(unsigned* p, unsigned v) { return __hip_atomic_fetch_add(p, v, __ATOMIC_RELAXED, __HIP_MEMORY_SCOPE_AGENT); }
__device__ __forceinline__ unsigned xb_xcc_id() { return (unsigned)__builtin_amdgcn_s_getreg((3 << 11) | 20) & 0xFu; }
#define XB_SPIN(cond, bar) do { unsigned _sp = 0; while (cond) { __builtin_amdgcn_s_sleep(1); \
    if ((++_sp & 255u) == 0u) { if (xb_ld(&(bar)[XB_TMO])) break; if (_sp > XB_SPIN_CAP) { atomicAdd(&(bar)[XB_TMO], 1u); break; } } } } while (0)
struct XcdBarrier { unsigned* bar; unsigned x; volatile LAS unsigned* st; };
__device__ __forceinline__ XcdBarrier xcd_barrier_post(unsigned* bar, volatile LAS unsigned* st, int tid) {
  XcdBarrier b; b.bar = bar; b.x = xb_xcc_id(); b.st = st;
  if (tid == 0) (void)xb_add(&bar[XB_XCNT(b.x)], 1u);
  return b;
}
__device__ __forceinline__ void xcd_barrier_complete(unsigned* bar, unsigned x, unsigned& nloc, unsigned& nx) {
  const unsigned G = gridDim.x * gridDim.y * gridDim.z;
  unsigned sum, cnt, mine, sp = 0u;
  for (;;) {
    sum = 0u; cnt = 0u; mine = 0u;
#pragma unroll
    for (unsigned j = 0; j < 16; ++j) { const unsigned c = xb_ld(&bar[XB_XCNT(j)]); sum += c; cnt += (c > 0u) ? 1u : 0u; mine = (j == x) ? c : mine; }
    if (sum == G) break;
    __builtin_amdgcn_s_sleep(1);
    if ((++sp & 255u) == 0u) { if (xb_ld(&bar[XB_TMO])) break; if (sp > XB_SPIN_CAP) { atomicAdd(&bar[XB_TMO], 1u); break; } }
  }
  nloc = mine > 0u ? mine : 1u; nx = cnt > 0u ? cnt : 1u;
}
__device__ __forceinline__ void xcd_barrier(const XcdBarrier& b, int swid) {
  asm volatile("s_waitcnt vmcnt(0)" ::: "memory");
  __syncthreads();
  if (opaque_tid(swid) == 0) {
    unsigned* bar = b.bar;
    __builtin_amdgcn_s_waitcnt(0);
    unsigned nloc = b.st[0], nx = b.st[1];
    if (nloc == 0u) { xcd_barrier_complete(bar, b.x, nloc, nx); b.st[0] = nloc; b.st[1] = nx; }
    const unsigned old = xb_add(&bar[XB_XSUB(b.x)], 1u);
    const unsigned gen = old / nloc;
    if (old + 1u == (gen + 1u) * nloc) {
      __builtin_amdgcn_fence(__ATOMIC_RELEASE, "agent");
      asm volatile("s_waitcnt vmcnt(0)" ::: "memory");
      const unsigned og = xb_add(&bar[XB_TOP], 1u);
      const unsigned tg = og / nx;
      if (og + 1u == (tg + 1u) * nx) xb_add(&bar[XB_TOPGEN], 1u);
      else XB_SPIN(xb_ld(&bar[XB_TOPGEN]) == tg, bar);
      __builtin_amdgcn_fence(__ATOMIC_ACQUIRE, "agent");
      xb_add(&bar[XB_XGEN(b.x)], 1u);
      asm volatile("s_waitcnt vmcnt(0)" ::: "memory");
    } else {
      XB_SPIN(xb_ld(&bar[XB_XGEN(b.x)]) == gen, bar);
      __builtin_amdgcn_fence(__ATOMIC_ACQUIRE, "agent");
      asm volatile("s_waitcnt vmcnt(0)" ::: "memory");
    }
  }
  __syncthreads();
}

__device__ __forceinline__ void tp_tile(const float* __restrict__ src, int lds_, int k0, int n0, f16* __restrict__ dst, int ldd, int drow0,
                                        const float* __restrict__ scale, float* tile, int swid) {
  const int t = opaque_tid(swid);
#pragma unroll
  for (int p = 0; p < 2; ++p) {
    const int r = (t >> 4) + 32 * p, c4 = (t & 15) * 4;
    const f32x4 v = *(const f32x4*)(src + (size_t)(k0 + r) * lds_ + n0 + c4);
    tile[r * 65 + c4 + 0] = v[0]; tile[r * 65 + c4 + 1] = v[1]; tile[r * 65 + c4 + 2] = v[2]; tile[r * 65 + c4 + 3] = v[3];
  }
  __syncthreads();
  {
    const int n = t >> 3, k8 = (t & 7) * 8;
    const float sc = scale ? scale[n0 + n] : 1.0f;
    f16x8 o;
#pragma unroll
    for (int i = 0; i < 8; ++i) o[i] = (f16)(tile[(k8 + i) * 65 + n] * sc);
    *(f16x8*)(dst + (size_t)(drow0 + n) * ldd + k0 + k8) = o;
  }
  __syncthreads();
}

__device__ __forceinline__ void phase_weights(const Args& a, float* tile, int swid) {
  constexpr int T_IN = 16 * 112, T_SQ = 16 * 16, T_UP = 16 * 88, T_DN = 44 * 16, T_PL = 4 * 16;
  constexpr int T_LAYER = T_IN + 3 * T_SQ + T_UP + T_DN + T_PL;
  unsigned char* ws = a.ws;
  for (int idx = blockIdx.x; idx < 2 * T_LAYER; idx += gridDim.x) {
    const int l = idx / T_LAYER; int j = idx % T_LAYER;
    if (j < T_IN) { const int kt = j / 112, nt = j % 112;
      tp_tile(a.w_in + (size_t)l * DM * INW, INW, kt * 64, nt * 64, (f16*)(ws + WS_WIN) + (size_t)l * INW * DM, DM, nt * 64, nullptr, tile, swid); continue; }
    j -= T_IN;
    if (j < 3 * T_SQ) { const int w = j / T_SQ, jj = j % T_SQ, kt = jj / 16, nt = jj % 16;
      const float* src = (w == 0 ? a.w_a : (w == 1 ? a.w_b : a.w_out)) + (size_t)l * DM * DM;
      f16* dst = (f16*)(ws + (w == 0 ? WS_WA : (w == 1 ? WS_WB : WS_WO))) + (size_t)l * DM * DM;
      tp_tile(src, DM, kt * 64, nt * 64, dst, DM, nt * 64, nullptr, tile, swid); continue; }
    j -= 3 * T_SQ;
    if (j < T_UP) { const int kt = j / 88, nt = j % 88; const int n0 = nt * 64, bj = n0 / DFF, rem = n0 % DFF, p = rem / 128, j0 = rem % 128;
      tp_tile(a.w_up + (size_t)l * DM * NUP, NUP, kt * 64, n0, (f16*)(ws + WS_WUP) + (size_t)l * NUP * DM, DM, p * 256 + bj * 128 + j0, nullptr, tile, swid); continue; }
    j -= T_UP;
    if (j < T_DN) { const int kt = j / 16, nt = j % 16;
      tp_tile(a.w_down + (size_t)l * DFF * DM, DM, kt * 64, nt * 64, (f16*)(ws + WS_WDN) + (size_t)l * DM * DFF, DFF, nt * 64, nullptr, tile, swid); continue; }
    j -= T_DN;
    { const int g = j / 16, jj = j % 16, kt = jj / 4, nt = jj % 4;
      tp_tile(a.pool_w + ((size_t)l * 4 + g) * 256 * 256, 256, kt * 64, nt * 64, (f16*)(ws + WS_WP) + ((size_t)l * 4 + g) * 256 * 256, 256, nt * 64,
              a.pool_scale + (size_t)l * DM + g * 256, tile, swid); }
  }
}

__device__ __forceinline__ int row_kind(const Round& R, int row, int& s, int& o) {
  if (row < 64) { s = row >> 4; o = row & 15; return s < R.nseq ? 1 : 0; }
  if (row < RB) return 0;
  const int q = row - RB; s = q / R.S; o = q - s * R.S; return 2;
}
__device__ __forceinline__ const float* x_row(const Args& a, const Round& R, int s, int i) {
  return R.is_sample ? a.x_sample + ((size_t)R.b0 * 16384 + i) * DM : a.x_prompt + ((size_t)(R.b0 + s) * 4096 + i) * DM;
}
__device__ __forceinline__ float* out_row(const Args& a, const Round& R, int s, int i) {
  return R.is_sample ? a.out + (size_t)8 * 4096 * DM + ((size_t)R.b0 * 16384 + i) * DM : a.out + ((size_t)(R.b0 + s) * 4096 + i) * DM;
}
__device__ __forceinline__ void store_h(const Args& a, int row, int lane, const f32x4 (&v)[4]) {
  float* h32 = (float*)(a.ws + WS_H32) + (size_t)row * DM; f16* h16 = (f16*)(a.ws + WS_H16) + (size_t)row * DM;
#pragma unroll
  for (int i = 0; i < 4; ++i) { const int c = i * 256 + lane * 4;
    *(f32x4*)(h32 + c) = v[i];
    f16x4 h = {(f16)v[i][0], (f16)v[i][1], (f16)v[i][2], (f16)v[i][3]}; *(f16x4*)(h16 + c) = h; }
}
__device__ __forceinline__ void init_row(const Args& a, const Round& R, int row, int lane) {
  int s = 0, o = 0; const int kd = row_kind(R, row, s, o);
  f32x4 v[4];
  const float* src = kd == 1 ? a.meta + (size_t)o * DM : (kd == 2 ? x_row(a, R, s, o) : nullptr);
#pragma unroll
  for (int i = 0; i < 4; ++i) v[i] = src ? *(const f32x4*)(src + i * 256 + lane * 4) : (f32x4){0.f, 0.f, 0.f, 0.f};
  store_h(a, row, lane, v);
}
__device__ __forceinline__ void ln_row(const Args& a, const Round& R, int row, int lane, const float* __restrict__ g, const float* __restrict__ b, int to_out, int dry) {
  const float* h32 = (const float*)(a.ws + WS_H32) + (size_t)row * DM;
  f32x4 v[4]; float s = 0.f;
#pragma unroll
  for (int i = 0; i < 4; ++i) { v[i] = *(const f32x4*)(h32 + i * 256 + lane * 4); s += (v[i][0] + v[i][1]) + (v[i][2] + v[i][3]); }
#pragma unroll
  for (int o = 32; o >= 1; o >>= 1) s += __shfl_xor(s, o);
  const float mu = s * (1.0f / DM); float q = 0.f;
#pragma unroll
  for (int i = 0; i < 4; ++i) { const f32x4 d = v[i] - mu; q += (d[0] * d[0] + d[1] * d[1]) + (d[2] * d[2] + d[3] * d[3]); }
#pragma unroll
  for (int o = 32; o >= 1; o >>= 1) q += __shfl_xor(q, o);
  const float rstd = 1.0f / sqrtf(q * (1.0f / DM) + 1e-5f);
#pragma unroll
  for (int i = 0; i < 4; ++i) { const f32x4 gg = *(const f32x4*)(g + i * 256 + lane * 4), bb = *(const f32x4*)(b + i * 256 + lane * 4); v[i] = (v[i] - mu) * rstd * gg + bb; }
  if (dry) return;
  if (!to_out) { store_h(a, row, lane, v); return; }
  int sq = 0, o = 0; const int kd = row_kind(R, row, sq, o);
  if (kd == 2) { float* dst = out_row(a, R, sq, o);
#pragma unroll
    for (int i = 0; i < 4; ++i) *(f32x4*)(dst + i * 256 + lane * 4) = v[i]; }
}
__device__ __forceinline__ void phase_rows(const Args& a, const Round& R, int mode, const float* g, const float* b, int rn, int swid, int dry = 0) {
  const int tid_ = opaque_tid(swid); const int wid = tid_ >> 6, lane = tid_ & 63;
  const int nw = gridDim.x * 8;
  if (mode != 0) for (int v = blockIdx.x * 8 + wid; v < MROWS - 64; v += nw) ln_row(a, R, v < 64 ? v : v + 64, lane, g, b, mode == 2, dry);
  if (mode == 1 || rn < 0 || dry) return;
  const Round Rn = get_round(rn);
  for (int v = blockIdx.x * 8 + wid; v < MROWS - 64; v += nw) init_row(a, Rn, v < 64 ? v : v + 64, lane);
}

constexpr int BM = 256, BK = 64, HALF = 128, HTB = HALF * BK * 2, NXCD = 8, WGM = 8;
__device__ __forceinline__ int lds_byte(int r, int c) { const int st = (r >> 4) * 2 + (c >> 5), rr = r & 15, cc = c & 31, ob = rr * 64 + cc * 2; return st * 1024 + (ob ^ (((ob >> 9) & 1) << 5)); }
__device__ __forceinline__ void stage_rc(int b, int& R, int& C) { const int st = b / 1024, sb = b % 1024, swz = sb ^ (((sb >> 9) & 1) << 5); R = (st >> 1) * 16 + swz / 64; C = (st & 1) * 32 + (swz % 64) / 2; }

struct GUnit { const char* A; const char* B; int pm, pn; };

__device__ __forceinline__ void tile_map(int L, int nM, int nN, int& pm, int& pn) {
  const int nwg = nM * nN; int wgid = L;
  { const int q = nwg / NXCD, r = nwg % NXCD, xcd = wgid % NXCD, off = wgid / NXCD; wgid = (xcd < r ? xcd * (q + 1) : r * (q + 1) + (xcd - r) * q) + off; }
  const int nig = WGM * nN, gid = wgid / nig, fm = gid * WGM, gsz = (nM - fm) < WGM ? (nM - fm) : WGM;
  pm = fm + ((wgid % nig) % gsz); pn = (wgid % nig) / gsz;
}

#ifndef GEMM_SP2
#define GEMM_SP2 1
#endif
#ifndef GEMM_ALIGN
#define GEMM_ALIGN 1
#endif
template <int LDA2, int LDB2, int NT, class Sched, class Epi>
__device__ __forceinline__ void gemm_phase(LAS unsigned char* lds, const Sched& S, const Epi& E, int swid) {
  const int tid = opaque_tid(swid), wid = __builtin_amdgcn_readfirstlane(tid >> 6), lane = tid & 63, wr = wid >> 2, wc = wid & 3, fr = lane & 15, fq = lane >> 4;
  unsigned voffA[2], voffB[2];
#pragma unroll
  for (int i = 0; i < 2; ++i) { int R, C; stage_rc(tid * 16 + i * 8192, R, C); voffA[i] = (unsigned)(R * LDA2 + C * 2); voffB[i] = (unsigned)(R * LDB2 + C * 2); }
  constexpr size_t kstep = (size_t)(BK * 2);
  constexpr size_t hA = (size_t)HALF * LDA2, hB = (size_t)HALF * LDB2;
  const unsigned ldsw = (unsigned)wid * 1024u;
  const int aoff = lds_byte(wr * 64 + fr, fq * 8), boff = lds_byte(wc * 32 + fr, fq * 8);
#define G_SA(b, h) (((b) * 2 + (h)) * HTB)
#define G_SB(b, h) ((4 + (b) * 2 + (h)) * HTB)
#define G_STAGE(bufoff, gbase, voff) do { _Pragma("unroll") for (int _i = 0; _i < 2; ++_i) \
    __builtin_amdgcn_global_load_lds((const unsigned*)((const char*)(gbase) + (voff)[_i]), (LAS unsigned*)(lds + (bufoff) + ldsw + _i * 8192), 16, 0, 0); } while (0)
#define G_LDA(dst, b, h) do { _Pragma("unroll") for (int m = 0; m < 4; ++m) _Pragma("unroll") for (int k = 0; k < 2; ++k) dst[m][k] = *(const LAS f16x8*)(lds + G_SA(b, h) + aoff + m * 2048 + k * 1024); } while (0)
#define G_LDB(dst, b, h) do { _Pragma("unroll") for (int n = 0; n < 2; ++n) _Pragma("unroll") for (int k = 0; k < 2; ++k) dst[n][k] = *(const LAS f16x8*)(lds + G_SB(b, h) + boff + n * 2048 + k * 1024); } while (0)
#define G_MMA(ai, bj, At, Bt) do { __builtin_amdgcn_s_setprio(1); _Pragma("unroll") for (int m = 0; m < 4; ++m) _Pragma("unroll") for (int n = 0; n < 2; ++n) _Pragma("unroll") for (int k = 0; k < 2; ++k) \
    acc[ai][bj][m][n] = __builtin_amdgcn_mfma_f32_16x16x32_f16(Bt[n][k], At[m][k], acc[ai][bj][m][n], 0, 0, 0); __builtin_amdgcn_s_setprio(0); } while (0)
#define G_WAIT_V(n) asm volatile("s_waitcnt vmcnt(" #n ")" ::: "memory")
#define G_WAIT_L(n) asm volatile("s_waitcnt lgkmcnt(" #n ")" ::: "memory")
#define G_BAR __builtin_amdgcn_s_barrier()
#define G_SCHED __builtin_amdgcn_sched_barrier(0)
  GUnit cur, nxt; int ui = 0;
  if (!S.next(0, cur)) return;
  f32x4 acc[2][2][4][2];
#pragma unroll
  for (int a = 0; a < 2; ++a)
#pragma unroll
    for (int b = 0; b < 2; ++b)
#pragma unroll
      for (int m = 0; m < 4; ++m)
#pragma unroll
        for (int n = 0; n < 2; ++n) acc[a][b][m][n] = (f32x4){0.f, 0.f, 0.f, 0.f};
  f16x8 At[4][2], B0[2][2], B1[2][2];
  const char* cA = cur.A; const char* cB = cur.B;
  if (GEMM_SP2) {
    G_STAGE(G_SB(0, 0), cB, voffB); G_STAGE(G_SB(0, 1), cB + hB, voffB); G_STAGE(G_SA(0, 0), cA, voffA); G_STAGE(G_SA(0, 1), cA + hA, voffA);
    if (wr == 1) G_BAR;
    G_WAIT_V(2); G_BAR;
    G_STAGE(G_SB(1, 0), cB + kstep, voffB); G_STAGE(G_SA(1, 0), cA + kstep, voffA); G_STAGE(G_SB(1, 1), cB + hB + kstep, voffB);
    G_WAIT_V(6); G_BAR;
  } else {
    G_STAGE(G_SB(0, 0), cB, voffB); G_STAGE(G_SA(0, 0), cA, voffA); G_STAGE(G_SB(0, 1), cB + hB, voffB); G_STAGE(G_SA(0, 1), cA + hA, voffA);
    if (wr == 1) G_BAR;
    G_WAIT_V(4); G_BAR;
    G_STAGE(G_SB(1, 0), cB + kstep, voffB); G_STAGE(G_SA(1, 0), cA + kstep, voffA); G_STAGE(G_SB(1, 1), cB + hB + kstep, voffB);
    G_WAIT_V(6); G_BAR;
  }
  for (;;) {
    const bool has_next = S.next(ui + 1, nxt);
    const char* nA = has_next ? nxt.A : cA; const char* nB = has_next ? nxt.B : cB;
#pragma unroll 1
    for (int t = 0; t < NT; t += 2) {
      const bool last = (t == NT - 2);
      const char* a1 = cA + (size_t)(t + 1) * kstep;
      const char* a2 = last ? nA : cA + (size_t)(t + 2) * kstep; const char* b2 = last ? nB : cB + (size_t)(t + 2) * kstep;
      const char* a3 = a2 + kstep; const char* b3 = b2 + kstep;
      if (GEMM_SP2) {
      G_LDB(B0, 0, 0); G_LDB(B1, 0, 1); G_SCHED; G_LDA(At, 0, 0); G_STAGE(G_SA(1, 1), a1 + hA, voffA);
      G_WAIT_V(8); G_WAIT_L(0); G_BAR; G_MMA(0, 0, At, B0); G_MMA(0, 1, At, B1); G_BAR; G_SCHED;
      G_LDA(At, 0, 1); G_STAGE(G_SB(0, 0), b2, voffB); G_STAGE(G_SB(0, 1), b2 + hB, voffB); G_STAGE(G_SA(0, 0), a2, voffA);
      G_WAIT_V(8); G_WAIT_L(0); G_BAR; G_MMA(1, 0, At, B0); G_MMA(1, 1, At, B1); G_BAR; G_SCHED;
      G_LDB(B0, 1, 0); G_LDB(B1, 1, 1); G_SCHED; G_LDA(At, 1, 0); G_STAGE(G_SA(0, 1), a2 + hA, voffA);
      G_WAIT_V(8); G_WAIT_L(0); G_BAR; G_MMA(0, 0, At, B0); G_MMA(0, 1, At, B1); G_BAR; G_SCHED;
      G_LDA(At, 1, 1); G_STAGE(G_SB(1, 0), b3, voffB); G_STAGE(G_SB(1, 1), b3 + hB, voffB); G_STAGE(G_SA(1, 0), a3, voffA);
      G_WAIT_V(8); G_WAIT_L(0); G_BAR; G_MMA(1, 0, At, B0); G_MMA(1, 1, At, B1); G_BAR; G_SCHED;
      } else {
      G_LDB(B0, 0, 0); G_SCHED; G_LDA(At, 0, 0); G_STAGE(G_SA(1, 1), a1 + hA, voffA);
      G_WAIT_L(8); G_BAR; G_WAIT_L(0); G_MMA(0, 0, At, B0); G_BAR; G_SCHED;
      G_LDB(B1, 0, 1); G_STAGE(G_SB(0, 0), b2, voffB);
      G_BAR; G_WAIT_L(0); G_MMA(0, 1, At, B1); G_BAR;
      G_LDA(At, 0, 1); G_STAGE(G_SA(0, 0), a2, voffA);
      G_BAR; G_WAIT_L(0); G_MMA(1, 0, At, B0); G_BAR; G_SCHED;
      G_STAGE(G_SB(0, 1), b2 + hB, voffB);
      G_WAIT_V(6); G_BAR; G_MMA(1, 1, At, B1); G_BAR;
      G_LDB(B0, 1, 0); G_SCHED; G_LDA(At, 1, 0); G_STAGE(G_SA(0, 1), a2 + hA, voffA);
      G_WAIT_L(8); G_BAR; G_WAIT_L(0); G_MMA(0, 0, At, B0); G_BAR; G_SCHED;
      G_LDB(B1, 1, 1); G_STAGE(G_SB(1, 0), b3, voffB);
      G_BAR; G_WAIT_L(0); G_MMA(0, 1, At, B1); G_BAR;
      G_LDA(At, 1, 1); G_STAGE(G_SA(1, 0), a3, voffA);
      G_BAR; G_WAIT_L(0); G_MMA(1, 0, At, B0); G_BAR; G_SCHED;
      G_STAGE(G_SB(1, 1), b3 + hB, voffB);
      G_WAIT_V(6); G_BAR; G_MMA(1, 1, At, B1); G_BAR;
      }
    }
    if (GEMM_ALIGN) { if (wr == 0) G_BAR; }
    E(acc, cur, wr, wc, fr, fq);
    if (!has_next) break;
#pragma unroll
    for (int a = 0; a < 2; ++a)
#pragma unroll
      for (int b = 0; b < 2; ++b)
#pragma unroll
        for (int m = 0; m < 4; ++m)
#pragma unroll
          for (int n = 0; n < 2; ++n) acc[a][b][m][n] = (f32x4){0.f, 0.f, 0.f, 0.f};
    cur = nxt; cA = nA; cB = nB; ++ui;
    if (GEMM_ALIGN) { if (wr == 1) G_BAR; }
  }
  G_WAIT_V(0);
  if (!GEMM_ALIGN) { if (wr == 0) G_BAR; }
  G_BAR;
#undef G_SA
#undef G_SB
#undef G_STAGE
#undef G_LDA
#undef G_LDB
#undef G_MMA
#undef G_WAIT_V
#undef G_WAIT_L
#undef G_BAR
#undef G_SCHED
}

template <int PH> struct Sched {
  const unsigned char* ws; int l, nM, G, c;
  __device__ __forceinline__ bool next(int i, GUnit& u) const {
    constexpr int nN = PH == 1 ? 28 : (PH == 7 ? 22 : 4);
    const long L = (long)i * G + c; if (L >= (long)nM * nN) return false;
    int pm, pn; tile_map((int)L, nM, nN, pm, pn);
    u.pm = pm; u.pn = pn;
    if (PH == 1)  { u.A = (const char*)(ws + WS_H16) + (size_t)(RB + pm * 256) * DM * 2; u.B = (const char*)(ws + WS_WIN) + ((size_t)l * INW + (size_t)pn * 256) * DM * 2; }
    if (PH == 40) { u.A = (const char*)(ws + WS_U) + ((size_t)(RB + pm * 256) * INW + C_QA) * 2; u.B = (const char*)(ws + WS_WA) + ((size_t)l * DM + (size_t)pn * 256) * DM * 2; }
    if (PH == 41) { u.A = (const char*)(ws + WS_U) + ((size_t)(RB + pm * 256) * INW + C_QB) * 2; u.B = (const char*)(ws + WS_WB) + ((size_t)l * DM + (size_t)pn * 256) * DM * 2; }
    if (PH == 42) { u.A = (const char*)(ws + WS_PD) + ((size_t)(RB + pm * 256) * DM + pn * 256) * 2; u.B = (const char*)(ws + WS_WP) + ((size_t)l * 4 + pn) * 256 * 256 * 2; }
    if (PH == 5)  { u.A = (const char*)(ws + WS_MG) + (size_t)(RB + pm * 256) * DM * 2; u.B = (const char*)(ws + WS_WO) + ((size_t)l * DM + (size_t)pn * 256) * DM * 2; }
    if (PH == 7)  { u.A = (const char*)(ws + WS_H16) + (size_t)(RB + pm * 256) * DM * 2; u.B = (const char*)(ws + WS_WUP) + ((size_t)l * NUP + (size_t)pn * 256) * DM * 2; }
    if (PH == 8)  { u.A = (const char*)(ws + WS_U) + (size_t)(RB + pm * 256) * DFF * 2; u.B = (const char*)(ws + WS_WDN) + ((size_t)l * DM + (size_t)pn * 256) * DFF * 2; }
    return true;
  }
};

__device__ __forceinline__ f16x4 to_h4(f32x4 v) { f16x4 h = {(f16)v[0], (f16)v[1], (f16)v[2], (f16)v[3]}; return h; }
__device__ __forceinline__ f32x4 to_f4(f16x4 h) { f32x4 v = {(float)h[0], (float)h[1], (float)h[2], (float)h[3]}; return v; }
struct EpiU { int dry;
  unsigned char* ws;
  __device__ __forceinline__ void operator()(const f32x4 (&acc)[2][2][4][2], const GUnit& u, int wr, int wc, int fr, int fq) const {
    if (dry) return;
    f16* U = (f16*)(ws + WS_U);
    const int row0 = RB + u.pm * BM + wr * 64 + fr, col0 = u.pn * BM + wc * 32 + 4 * fq;
#pragma unroll
    for (int ai = 0; ai < 2; ++ai)
#pragma unroll
      for (int m = 0; m < 4; ++m) { f16* rowp = U + (size_t)(row0 + ai * HALF + m * 16) * INW + col0;
#pragma unroll
        for (int bj = 0; bj < 2; ++bj)
#pragma unroll
          for (int n = 0; n < 2; ++n) *(f16x4*)(rowp + bj * HALF + n * 16) = to_h4(acc[ai][bj][m][n]); }
  }
};
template <int KIND> struct EpiGate { int dry;
  unsigned char* ws;
  __device__ __forceinline__ void operator()(const f32x4 (&acc)[2][2][4][2], const GUnit& u, int wr, int wc, int fr, int fq) const {
    if (dry) return;
    const f16* U = (const f16*)(ws + WS_U); f16* MG = (f16*)(ws + WS_MG);
    const int row0 = RB + u.pm * BM + wr * 64 + fr, col0 = u.pn * BM + wc * 32 + 4 * fq;
    constexpr int kind = KIND;
#pragma unroll
    for (int ai = 0; ai < 2; ++ai)
#pragma unroll
      for (int m = 0; m < 4; ++m) { const size_t row = (size_t)(row0 + ai * HALF + m * 16);
        const f16* gp = U + row * INW + C_UG + kind * DM + col0; f16* mp = MG + row * DM + col0;
#pragma unroll
        for (int bj = 0; bj < 2; ++bj)
#pragma unroll
          for (int n = 0; n < 2; ++n) { const f32x4 g = to_f4(*(const f16x4*)(gp + bj * HALF + n * 16)); f32x4 v = acc[ai][bj][m][n];
#pragma unroll
            for (int j = 0; j < 4; ++j) v[j] = v[j] / (1.0f + __expf(-g[j]));
            if (kind != 0) v += to_f4(*(const f16x4*)(mp + bj * HALF + n * 16));
            *(f16x4*)(mp + bj * HALF + n * 16) = to_h4(v); } }
  }
};
struct EpiResid { int dry;
  unsigned char* ws;
  __device__ __forceinline__ void operator()(const f32x4 (&acc)[2][2][4][2], const GUnit& u, int wr, int wc, int fr, int fq) const {
    if (dry) return;
    float* H = (float*)(ws + WS_H32);
    const int row0 = RB + u.pm * BM + wr * 64 + fr, col0 = u.pn * BM + wc * 32 + 4 * fq;
#pragma unroll
    for (int ai = 0; ai < 2; ++ai)
#pragma unroll
      for (int m = 0; m < 4; ++m) { float* rowp = H + (size_t)(row0 + ai * HALF + m * 16) * DM + col0;
#pragma unroll
        for (int bj = 0; bj < 2; ++bj)
#pragma unroll
          for (int n = 0; n < 2; ++n) { const f32x4 o = *(const f32x4*)(rowp + bj * HALF + n * 16); *(f32x4*)(rowp + bj * HALF + n * 16) = o * ALPHA + acc[ai][bj][m][n]; } }
  }
};
struct EpiSwiglu { int dry;
  unsigned char* ws;
  __device__ __forceinline__ void operator()(const f32x4 (&acc)[2][2][4][2], const GUnit& u, int wr, int wc, int fr, int fq) const {
    if (dry) return;
    f16* HID = (f16*)(ws + WS_U);
    const int row0 = RB + u.pm * BM + wr * 64 + fr, col0 = u.pn * HALF + wc * 32 + 4 * fq;
#pragma unroll
    for (int ai = 0; ai < 2; ++ai)
#pragma unroll
      for (int m = 0; m < 4; ++m) { f16* rowp = HID + (size_t)(row0 + ai * HALF + m * 16) * DFF + col0;
#pragma unroll
        for (int n = 0; n < 2; ++n) { const f32x4 g = acc[ai][0][m][n], up = acc[ai][1][m][n]; f32x4 v;
#pragma unroll
          for (int j = 0; j < 4; ++j) v[j] = g[j] / (1.0f + __expf(-g[j])) * up[j];
          *(f16x4*)(rowp + n * 16) = to_h4(v); } }
  }
};

__device__ __forceinline__ void slab_partial(const f16* __restrict__ A, int lda, const f16* __restrict__ B, int ldb, int kbeg, int kend, int fr, int fq, f32x4 (&acc)[4]) {
  for (int k = kbeg; k < kend; k += 32) {
    const f16x8 w = *(const f16x8*)(B + (size_t)fr * ldb + k + fq * 8);
#pragma unroll
    for (int mb = 0; mb < 4; ++mb) { const f16x8 av = *(const f16x8*)(A + (size_t)(mb * 16 + fr) * lda + k + fq * 8);
      acc[mb] = __builtin_amdgcn_mfma_f32_16x16x32_f16(w, av, acc[mb], 0, 0, 0); }
  }
}
__device__ __forceinline__ void slab_reduce(const f32x4 (&acc)[4], float* red, int tid, float& v0, float& v1) {
  const int wid = tid >> 6, lane = tid & 63;
  __syncthreads();
#pragma unroll
  for (int mb = 0; mb < 4; ++mb) *(f32x4*)(red + ((wid * 4 + mb) * 64 + lane) * 4) = acc[mb];
  __syncthreads();
  float v[2];
#pragma unroll
  for (int i = 0; i < 2; ++i) { const int e = tid + 512 * i, row = e >> 4, col = e & 15, mb = row >> 4, fr = row & 15, fq = col >> 2, j = col & 3; float s = 0.f;
#pragma unroll
    for (int w = 0; w < 8; ++w) s += red[((w * 4 + mb) * 64 + fq * 16 + fr) * 4 + j];
    v[i] = s; }
  v0 = v[0]; v1 = v[1];
}
__device__ __forceinline__ void slab_full(const f16* A, int lda, const f16* B, int ldb, int K, float* red, int tid, float& v0, float& v1) {
  const int wid = tid >> 6, lane = tid & 63, fr = lane & 15, fq = lane >> 4;
  f32x4 acc[4];
#pragma unroll
  for (int mb = 0; mb < 4; ++mb) acc[mb] = (f32x4){0.f, 0.f, 0.f, 0.f};
  const int ks = K >> 3;
  slab_partial(A, lda, B, ldb, wid * ks, wid * ks + ks, fr, fq, acc);
  slab_reduce(acc, red, tid, v0, v1);
}
template <int PH>
__device__ __forceinline__ void meta_gemm(const Args& a, int l, float* red, int swid) {
  const int tid = opaque_tid(swid);
  unsigned char* ws = a.ws;
  f16* U = (f16*)(ws + WS_U); f16* MG = (f16*)(ws + WS_MG); float* H32 = (float*)(ws + WS_H32); const f16* H16 = (const f16*)(ws + WS_H16); const f16* PD = (const f16*)(ws + WS_PD);
  constexpr int NSLAB = PH == 1 ? INW / 16 : (PH == 7 ? DFF / 16 : DM / 16);
  for (int sl = blockIdx.x; sl < NSLAB; sl += gridDim.x) {
    const int n0 = sl * 16;
    float v[2], w[2], x[2];
    if (PH == 1) slab_full(H16, DM, (const f16*)(ws + WS_WIN) + ((size_t)l * INW + n0) * DM, DM, DM, red, tid, v[0], v[1]);
    if (PH == 4) {
      slab_full(U + C_QA, INW, (const f16*)(ws + WS_WA) + ((size_t)l * DM + n0) * DM, DM, DM, red, tid, v[0], v[1]);
      slab_full(U + C_QB, INW, (const f16*)(ws + WS_WB) + ((size_t)l * DM + n0) * DM, DM, DM, red, tid, w[0], w[1]);
      const int g = n0 >> 8;
      slab_full(PD + g * 256, DM, (const f16*)(ws + WS_WP) + ((size_t)l * 4 + g) * 256 * 256 + (size_t)(n0 & 255) * 256, 256, 256, red, tid, x[0], x[1]);
    }
    if (PH == 5) slab_full(MG, DM, (const f16*)(ws + WS_WO) + ((size_t)l * DM + n0) * DM, DM, DM, red, tid, v[0], v[1]);
    if (PH == 7) { const int p = n0 >> 7, j0 = n0 & 127;
      const f16* Bg = (const f16*)(ws + WS_WUP) + ((size_t)l * NUP + p * 256 + j0) * DM;
      slab_full(H16, DM, Bg, DM, DM, red, tid, v[0], v[1]);
      slab_full(H16, DM, Bg + (size_t)128 * DM, DM, DM, red, tid, w[0], w[1]); }
    if (PH == 8) slab_full(U, DFF, (const f16*)(ws + WS_WDN) + ((size_t)l * DM + n0) * DFF, DFF, DFF, red, tid, v[0], v[1]);
#pragma unroll
    for (int i = 0; i < 2; ++i) { const int e = tid + 512 * i, row = e >> 4, col = n0 + (e & 15);
      if (PH == 1) U[(size_t)row * INW + col] = (f16)v[i];
      if (PH == 4) { const f16* gp = U + (size_t)row * INW + C_UG + col;
        const float g0 = (float)gp[0], g1 = (float)gp[DM], g2 = (float)gp[2 * DM];
        MG[(size_t)row * DM + col] = (f16)(v[i] / (1.0f + __expf(-g0)) + w[i] / (1.0f + __expf(-g1)) + x[i] / (1.0f + __expf(-g2))); }
      if (PH == 5 || PH == 8) { float* hp = H32 + (size_t)row * DM + col; *hp = *hp * ALPHA + v[i]; }
      if (PH == 7) ((f16*)(ws + WS_U))[(size_t)row * DFF + col] = (f16)(v[i] / (1.0f + __expf(-v[i])) * w[i]); }
  }
  __syncthreads();
}

__device__ __forceinline__ float wave_sum(float s) {
#pragma unroll
  for (int o = 32; o >= 1; o >>= 1) s += __shfl_xor(s, o);
  return s;
}
__device__ __forceinline__ void sincos_turns(float ang, float& sn, float& cs) {
  const double t = (double)ang * 0.15915494309189533577;
  const float fr = (float)(t - floor(t));
  sn = __builtin_amdgcn_sinf(fr); cs = __builtin_amdgcn_cosf(fr);
}
__device__ __forceinline__ void phase_prep(const Args& a, const Round& R, int l, int dry, int swid) {
  const int tid_ = opaque_tid(swid); const int wid = tid_ >> 6, lane = tid_ & 63;
  f16* U = (f16*)(a.ws + WS_U); f16* PD = (f16*)(a.ws + WS_PD);
  const int L = R.S + 16, ntok = R.nseq * L;
  const int iA = lane & 31, secA = lane >> 5;
  const int dA1 = secA * 64 + iA, dA2 = dA1 + 32;
  const int dB1 = lane, dB2 = lane + 64;
  const float invA = (float)exp2(-(double)(2 * iA) / 64.0 * 13.287712379549449);
  const float invB = (float)exp2(-(double)(2 * lane) / 128.0 * 13.287712379549449);
  const float gq1 = a.qg[l * 128 + dA1], gq2 = a.qg[l * 128 + dA2], gk1 = a.kg[l * 128 + dA1], gk2 = a.kg[l * 128 + dA2];
  const int pg = lane >> 4, win = 2 << pg, c0 = lane * 16;
  for (int tok = blockIdx.x * 8 + wid; tok < ntok; tok += gridDim.x * 8) {
    const int s = tok / L, t = tok - s * L;
    const int mb_ = 16 * s, rb_ = RB + R.S * s - 16;
    const int row = t < 16 ? mb_ + t : rb_ + t;
    f16* up = U + (size_t)row * INW;
    int prow, pcol;
    if (t < 16) { prow = -1; pcol = t; } else { const int i = t - 16; prow = i >> 6; pcol = i & 63; }
    float snA, csA, snB, csB;
    sincos_turns((float)(secA ? pcol : prow) * invA, snA, csA);
    sincos_turns((float)t * invB, snB, csB);
#pragma unroll
    for (int h = 0; h < 10; ++h) {
      f16* p = up + (h < 8 ? C_QA + h * 128 : C_KA + (h - 8) * 128);
      float x1 = (float)p[dA1], x2 = (float)p[dA2];
      const float ss = wave_sum(x1 * x1 + x2 * x2);
      const float rs = 1.0f / sqrtf(ss * (1.0f / 128.0f) + 1e-6f);
      x1 = x1 * rs * (h < 8 ? gq1 : gk1); x2 = x2 * rs * (h < 8 ? gq2 : gk2);
      if (!dry) { p[dA1] = (f16)(x1 * csA - x2 * snA); p[dA2] = (f16)(x1 * snA + x2 * csA); }
    }
#pragma unroll
    for (int h = 0; h < 10; ++h) {
      f16* p = up + (h < 8 ? C_QB + h * 128 : C_KB + (h - 8) * 128);
      const float x1 = (float)p[dB1], x2 = (float)p[dB2];
      if (!dry) { p[dB1] = (f16)(x1 * csB - x2 * snB); p[dB2] = (f16)(x1 * snB + x2 * csB); }
    }
    {
      int lo = t - win / 2; int hi = lo + win; lo = lo < 0 ? 0 : lo; hi = hi > L ? L : hi;
      float acc[16];
#pragma unroll
      for (int j = 0; j < 16; ++j) acc[j] = 0.f;
      for (int tt = lo; tt < hi; ++tt) {
        const f16* q = U + (size_t)(tt < 16 ? mb_ + tt : rb_ + tt) * INW + C_UC + c0;
        const f16x8 v0 = *(const f16x8*)q, v1 = *(const f16x8*)(q + 8);
#pragma unroll
        for (int j = 0; j < 8; ++j) { acc[j] += (float)v0[j]; acc[8 + j] += (float)v1[j]; }
      }
      const float rc = 1.0f / (float)(hi - lo);
      const f16x8 s0 = *(const f16x8*)(up + C_UC + c0), s1 = *(const f16x8*)(up + C_UC + c0 + 8);
      f16x8 o0, o1;
#pragma unroll
      for (int j = 0; j < 8; ++j) { o0[j] = (f16)(acc[j] * rc - (float)s0[j]); o1[j] = (f16)(acc[8 + j] * rc - (float)s1[j]); }
      if (!dry) { *(f16x8*)(PD + (size_t)row * DM + c0) = o0; *(f16x8*)(PD + (size_t)row * DM + c0 + 8) = o1; }
    }
  }
}

constexpr int AD = 128, KVBLK = 64, LDQ = INW;
constexpr float ASCALE = 0.088388347648318440f;
constexpr float ATHR = 8.f;
constexpr int SHM_V = KVBLK * AD * 2, SHM_K = KVBLK * AD * 2;
typedef short s16x4 __attribute__((ext_vector_type(4)));
#define KSWZ(row, colB) ((row) * 256 + ((colB) ^ (((row) & 7) << 4)))
#define SBAR() __builtin_amdgcn_sched_barrier(0)
__device__ __forceinline__ int crow(int r, int hi) { return (r & 3) + 8 * (r >> 2) + 4 * hi; }
__device__ __forceinline__ unsigned cvtpk(float lo, float hi) { f16x2 v = {(f16)lo, (f16)hi}; return __builtin_bit_cast(unsigned, v); }

__device__ __forceinline__ void partialSM(f32x16& p0, f32x16& p1, float& m_reg, float& mn, float& alpha) {
  constexpr float C = ASCALE * 1.4426950408889634f;
  float pmax = p0[0];
#pragma unroll
  for (int r = 1; r < 16; ++r) pmax = fmaxf(pmax, p0[r]);
#pragma unroll
  for (int r = 0; r < 16; ++r) pmax = fmaxf(pmax, p1[r]);
  { auto rr = __builtin_amdgcn_permlane32_swap(__float_as_uint(pmax), __float_as_uint(pmax), false, false);
    pmax = fmaxf(__uint_as_float(rr[0]), __uint_as_float(rr[1])); }
  if (__builtin_expect(__all(pmax - m_reg <= ATHR / ASCALE), 1)) { mn = m_reg; alpha = 1.f; }
  else { mn = fmaxf(m_reg, pmax); alpha = __builtin_amdgcn_exp2f((m_reg - mn) * C); m_reg = mn; }
  const float mnC = -mn * C;
#pragma unroll
  for (int r = 0; r < 16; ++r) p0[r] = fmaf(p0[r], C, mnC);
#pragma unroll
  for (int r = 0; r < 16; ++r) p1[r] = fmaf(p1[r], C, mnC);
#pragma unroll
  for (int r = 0; r < 16; ++r) p0[r] = __builtin_amdgcn_exp2f(p0[r]);
}
__device__ __forceinline__ void finishSM(f32x16& p0, f32x16& p1, float alpha, float& l_reg, f16x8& pa0, f16x8& pa1, f16x8& pa2, f16x8& pa3) {
#pragma unroll
  for (int r = 0; r < 16; ++r) p1[r] = __builtin_amdgcn_exp2f(p1[r]);
  float ps = 0;
#pragma unroll
  for (int r = 0; r < 16; ++r) ps += p0[r];
#pragma unroll
  for (int r = 0; r < 16; ++r) ps += p1[r];
  { auto rr = __builtin_amdgcn_permlane32_swap(__float_as_uint(ps), __float_as_uint(ps), false, false);
    ps = __uint_as_float(rr[0]) + __uint_as_float(rr[1]); }
  l_reg = l_reg * alpha + ps;
#define PK4(P, BASE, OUT) do { unsigned a0 = cvtpk(P[BASE + 0], P[BASE + 1]), a1 = cvtpk(P[BASE + 2], P[BASE + 3]);   \
    unsigned b0 = cvtpk(P[BASE + 4], P[BASE + 5]), b1 = cvtpk(P[BASE + 6], P[BASE + 7]);                              \
    auto r0 = __builtin_amdgcn_permlane32_swap(a0, b0, false, false); auto r1 = __builtin_amdgcn_permlane32_swap(a1, b1, false, false); \
    u32x4 w = {r0[0], r1[0], r0[1], r1[1]}; OUT = __builtin_bit_cast(f16x8, w); } while (0)
  PK4(p0, 0, pa0); PK4(p0, 8, pa1); PK4(p1, 0, pa2); PK4(p1, 8, pa3);
#undef PK4
}
__device__ __forceinline__ void qkt(f32x16& p0, f32x16& p1, const char* Ks, const f16x8* qr, int r32, int hi) {
  p0 = f32x16{}; p1 = f32x16{};
#pragma unroll
  for (int d0 = 0; d0 < 8; ++d0) { const int cb = (d0 * 16 + hi * 8) * 2;
    const f16x8 b0 = *reinterpret_cast<const f16x8*>(Ks + KSWZ(r32, cb));
    const f16x8 b1 = *reinterpret_cast<const f16x8*>(Ks + KSWZ(32 + r32, cb));
    p0 = __builtin_amdgcn_mfma_f32_32x32x16_f16(b0, qr[d0], p0, 0, 0, 0);
    p1 = __builtin_amdgcn_mfma_f32_32x32x16_f16(b1, qr[d0], p1, 0, 0, 0); }
}
__device__ __forceinline__ void mask_tile(f32x16& p0, f32x16& p1, int ka, int kb, int hi) {
  const int a2 = ka - 4 * hi; const unsigned span = (unsigned)(kb - ka);
#pragma unroll
  for (int r = 0; r < 16; ++r) { const int c = (r & 3) + 8 * (r >> 2);
    p0[r] = ((unsigned)(c - a2) <= span && kb >= ka) ? p0[r] : -1e30f;
    p1[r] = ((unsigned)(c + 32 - a2) <= span && kb >= ka) ? p1[r] : -1e30f; }
}
__device__ __forceinline__ int v_st(int k, int c) { const int kk = (k & ~0xC) | ((k & 4) << 1) | ((k & 8) >> 1); return ((kk >> 3) * 4 + (c >> 5)) * 512 + ((kk & 7) * 32 + (c & 31)) * 2; }
__device__ __forceinline__ int v_rd_base(int lane) { return ((lane & 3) << 3) | (((lane >> 2) & 3) << 6) | (((lane >> 4) & 1) << 5) | (((lane >> 5) & 1) << 8); }
constexpr int v_rd_off(int d0, int ks, int half) { return d0 * 512 + ks * 4096 + half * 2048; }
template <int OFF> __device__ __forceinline__ s16x4 tr_read(int vb) {
  s16x4 r; asm volatile("ds_read_b64_tr_b16 %0, %1 offset:%2" : "=&v"(r) : "v"(vb), "i"(OFF) : "memory"); return r;
}
template <int D0> __device__ __forceinline__ void pv_one(f32x16& od, int vb, f16x8 pa0, f16x8 pa1, f16x8 pa2, f16x8 pa3) {
  const s16x4 l0 = tr_read<v_rd_off(D0, 0, 0)>(vb), h0 = tr_read<v_rd_off(D0, 0, 1)>(vb), l1 = tr_read<v_rd_off(D0, 1, 0)>(vb), h1 = tr_read<v_rd_off(D0, 1, 1)>(vb);
  const s16x4 l2 = tr_read<v_rd_off(D0, 2, 0)>(vb), h2 = tr_read<v_rd_off(D0, 2, 1)>(vb), l3 = tr_read<v_rd_off(D0, 3, 0)>(vb), h3 = tr_read<v_rd_off(D0, 3, 1)>(vb);
  asm volatile("s_waitcnt lgkmcnt(0)" ::: "memory"); SBAR();
  typedef short s16x8 __attribute__((ext_vector_type(8)));
#define PK(L, H) __builtin_bit_cast(f16x8, (s16x8){L[0], L[1], L[2], L[3], H[0], H[1], H[2], H[3]})
  od = __builtin_amdgcn_mfma_f32_32x32x16_f16(pa0, PK(l0, h0), od, 0, 0, 0);
  od = __builtin_amdgcn_mfma_f32_32x32x16_f16(pa1, PK(l1, h1), od, 0, 0, 0);
  od = __builtin_amdgcn_mfma_f32_32x32x16_f16(pa2, PK(l2, h2), od, 0, 0, 0);
  od = __builtin_amdgcn_mfma_f32_32x32x16_f16(pa3, PK(l3, h3), od, 0, 0, 0);
#undef PK
}
__device__ __forceinline__ void pv_d0(f32x16* o, int vb, f16x8 pa0, f16x8 pa1, f16x8 pa2, f16x8 pa3) {
  pv_one<0>(o[0], vb, pa0, pa1, pa2, pa3); pv_one<1>(o[1], vb, pa0, pa1, pa2, pa3); pv_one<2>(o[2], vb, pa0, pa1, pa2, pa3); pv_one<3>(o[3], vb, pa0, pa1, pa2, pa3);
}

template <int MODE, int PART>
__device__ __forceinline__ void attn_body(const f16* Qb, const f16* __restrict__ KV, int kcol, int vcol, int NT, int tfirst, int tstart, int Tlast, int mrow, int rbase,
                                          int qoff, int wlo, int whi, int Sm1, float sink, int nvalid, float* part, char* lds, int swid) {
  const int tid = opaque_tid(swid), wid = tid >> 6, lane = tid & 63, r32 = lane & 31, hi = lane >> 5;
  char* V_lds = lds; char* K_lds = lds + 2 * SHM_V;
  float* wsf = (float*)(lds + 2 * SHM_V + 2 * SHM_K) + wid * 64; float* li_l = wsf; float* al_l = wsf + 32;
  float m_reg = -1e30f, l_reg = 0; f32x16 o[4] = {}; f16x8 qr[8];
  const f16* Qw = Qb + (size_t)(wid * 32 + r32) * LDQ + hi * 8;
#pragma unroll
  for (int d0 = 0; d0 < 8; ++d0) qr[d0] = *reinterpret_cast<const f16x8*>(Qw + d0 * 16);
  const int sr = tid >> 4, sc = (tid & 15) * 8, vst0 = v_st(sr, sc), vst1 = v_st(32 + sr, sc);
  const int vb0 = (int)(uintptr_t)V_lds + v_rd_base(lane);
  const f16* Kh = KV + kcol; const f16* Vh = KV + vcol;
  struct { f16x8 vs0, vs1, ks0, ks1; } sr_[2];
#define TIDX(j) ((j) == 0 ? tfirst : (tstart + (j)))
#define KROW(j) ({ int _t = TIDX(j); _t = _t >= Tlast ? Tlast - 1 : _t; (_t <= 0) ? mrow : rbase + (_t - 1) * KVBLK; })
#define SLOAD(i, j) do { const int _k0 = KROW(j); sr_[i].vs0 = *(const f16x8*)&Vh[(size_t)(_k0 + sr) * LDQ + sc]; sr_[i].vs1 = *(const f16x8*)&Vh[(size_t)(_k0 + 32 + sr) * LDQ + sc]; \
    sr_[i].ks0 = *(const f16x8*)&Kh[(size_t)(_k0 + sr) * LDQ + sc]; sr_[i].ks1 = *(const f16x8*)&Kh[(size_t)(_k0 + 32 + sr) * LDQ + sc]; } while (0)
#define SWRITE(b, i) do { *(f16x8*)(V_lds + (b) * SHM_V + vst0) = sr_[i].vs0;          \
    *(f16x8*)(V_lds + (b) * SHM_V + vst1) = sr_[i].vs1; const int kc = sc * 2;               \
    *(f16x8*)(K_lds + (b) * SHM_K + KSWZ(sr, kc)) = sr_[i].ks0;                       \
    *(f16x8*)(K_lds + (b) * SHM_K + KSWZ(32 + sr, kc)) = sr_[i].ks1; } while (0)
#define SWAIT() asm volatile("s_waitcnt vmcnt(4)" ::: "memory")
#define RESC(a) do { if (__any((a) < 1.f)) { if (hi == 0) al_l[r32] = (a); asm volatile("s_waitcnt lgkmcnt(0)" ::: "memory"); \
    _Pragma("unroll") for (int d = 0; d < 4; ++d) _Pragma("unroll") for (int r = 0; r < 16; ++r) o[d][r] *= al_l[crow(r, hi)]; } } while (0)
#define MASKJ(P0, P1, j) do { if (MODE == 1) { const int _kb = (TIDX(j) - 1) * KVBLK; const int _qi = qoff + wid * 32 + r32; int _lo = _qi - wlo; _lo = _lo < 0 ? 0 : _lo; int _hi = _qi + whi; _hi = _hi > Sm1 ? Sm1 : _hi; \
    mask_tile(P0, P1, _lo - _kb, _hi - _kb, hi); } } while (0)
  f32x16 pA0, pA1, pB0, pB1; float mnA, mnB, alA, alB; f16x8 pa0, pa1, pa2, pa3;
  constexpr int SE = 0, SO = 1;
  SLOAD(SE, 0); asm volatile("s_waitcnt vmcnt(0)" ::: "memory"); SWRITE(0, SE); __syncthreads();
  qkt(pA0, pA1, K_lds, qr, r32, hi); if (tfirst == 0) mask_tile(pA0, pA1, 0, 15, hi); partialSM(pA0, pA1, m_reg, mnA, alA);
  SLOAD(SO, 1); if (2 < NT) SLOAD(SE, 2);
  SWAIT(); SWRITE(1, SO); __syncthreads();
  for (int j = 1; j + 1 < NT; j += 2) {
    SBAR(); qkt(pB0, pB1, K_lds + SHM_K, qr, r32, hi); MASKJ(pB0, pB1, j);
    finishSM(pA0, pA1, alA, l_reg, pa0, pa1, pa2, pa3); SBAR();
    SLOAD(SO, j + 2); SBAR();
    pv_d0(o, vb0, pa0, pa1, pa2, pa3); partialSM(pB0, pB1, m_reg, mnB, alB);
    __syncthreads(); SWAIT(); SWRITE(0, SE);
    RESC(alB); __syncthreads();
    SBAR(); qkt(pA0, pA1, K_lds, qr, r32, hi); MASKJ(pA0, pA1, j + 1);
    finishSM(pB0, pB1, alB, l_reg, pa0, pa1, pa2, pa3); SBAR();
    if (j + 3 < NT) SLOAD(SE, j + 3); SBAR();
    pv_d0(o, vb0 + SHM_V, pa0, pa1, pa2, pa3); partialSM(pA0, pA1, m_reg, mnA, alA);
    __syncthreads(); SWAIT(); SWRITE(1, SO);
    RESC(alA); __syncthreads();
  }
  SBAR(); qkt(pB0, pB1, K_lds + SHM_K, qr, r32, hi);
  if (MODE == 0) { if (tstart + NT - 1 == Tlast) mask_tile(pB0, pB1, 1, 0, hi); } else MASKJ(pB0, pB1, NT - 1);
  finishSM(pA0, pA1, alA, l_reg, pa0, pa1, pa2, pa3); SBAR();
  pv_d0(o, vb0, pa0, pa1, pa2, pa3); partialSM(pB0, pB1, m_reg, mnB, alB);
  __syncthreads(); RESC(alB);
  finishSM(pB0, pB1, alB, l_reg, pa0, pa1, pa2, pa3); SBAR();
  pv_d0(o, vb0 + SHM_V, pa0, pa1, pa2, pa3);
  if (MODE == 1) l_reg += __builtin_amdgcn_exp2f(sink * 1.4426950408889634f - m_reg * (ASCALE * 1.4426950408889634f));
  if (hi == 0) li_l[r32] = l_reg; asm volatile("s_waitcnt lgkmcnt(0)" ::: "memory");
  float rli[16];
#pragma unroll
  for (int r = 0; r < 16; ++r) rli[r] = __builtin_amdgcn_rcpf(li_l[crow(r, hi)]);
  if (PART == 0) {
    f16* Ow = const_cast<f16*>(Qb) + (size_t)(wid * 32) * LDQ;
#pragma unroll
    for (int r = 0; r < 16; ++r) { const int orow = crow(r, hi);
      if (wid * 32 + orow < nvalid) {
#pragma unroll
        for (int d0 = 0; d0 < 4; ++d0) Ow[(size_t)orow * LDQ + d0 * 32 + r32] = (f16)(o[d0][r] * rli[r]); } }
  } else {
#pragma unroll
    for (int r = 0; r < 16; ++r) { const int orow = crow(r, hi);
      if (wid * 32 + orow < 16) {
#pragma unroll
        for (int d0 = 0; d0 < 4; ++d0) part[orow * 128 + d0 * 32 + r32] = o[d0][r] * rli[r]; } }
    if (tid < 16) { part[2048 + tid] = m_reg; part[2064 + tid] = l_reg; }
  }
  __syncthreads();
#undef SLOAD
#undef SWRITE
#undef SWAIT
#undef RESC
#undef MASKJ
#undef TIDX
#undef KROW
}

constexpr int PART_FLOATS = 2080;
#ifndef SPLITKV
#define SPLITKV 1
#endif
constexpr int CHUNK_T = 6;
__device__ __forceinline__ void phase_attn(const Args& a, const Round& R, int l, unsigned* counter, char* lds, int dry, int swid) {
  f16* U = (f16*)(a.ws + WS_U);
  float* PART = (float*)(a.ws + WS_PART);
  const int NQB = R.S / 256, per_seq = 8 * NQB;
  const int Tlast = R.S / 64 + 1, nchunk = (Tlast + 1) / CHUNK_T;
  const int nreal = R.nseq * per_seq, nmeta = (l == 0) ? R.nseq * 8 : 0, nmc = SPLITKV ? nmeta * nchunk : nmeta;
  const int total = nmc + 2 * nreal + nmeta;
  const int tid_ = opaque_tid(swid);
  unsigned* slot = (unsigned*)(lds + 131072);
  for (;;) {
    if (tid_ == 0) *slot = atomicAdd(counter, 1u);
    __syncthreads();
    const int idx = (int)*slot;
    __syncthreads();
    if (idx >= total) break;
    if (!SPLITKV && idx < nmc) {
      const int s = idx >> 3, head = idx & 7;
      const f16* Q = U + (size_t)(16 * s) * INW + C_QA + head * 128;
      attn_body<0, 0>(Q, U, C_KA + (head >> 2) * 128, C_VA + (head >> 2) * 128, Tlast + 1, 0, 0, Tlast, 16 * s, RB + R.S * s, 0, 0, 0, 0, 0.f, dry ? 0 : 16, nullptr, lds, swid);
      continue;
    }
    if (SPLITKV && idx < nmc) {
      const int u = idx / nchunk, c = idx - u * nchunk, s = u >> 3, head = u & 7;
      const f16* Q = U + (size_t)(16 * s) * INW + C_QA + head * 128;
      attn_body<0, 1>(Q, U, C_KA + (head >> 2) * 128, C_VA + (head >> 2) * 128, CHUNK_T, c * CHUNK_T, c * CHUNK_T, Tlast, 16 * s, RB + R.S * s,
                      0, 0, 0, 0, 0.f, 0, PART + (size_t)idx * PART_FLOATS, lds, swid);
      continue;
    }
    int k = idx - nmc;
    if (k < nreal) {
      const int s = k / per_seq, rem = k - s * per_seq, head = rem / NQB, qb = rem - head * NQB;
      const f16* Q = U + (size_t)(RB + R.S * s + qb * 256) * INW + C_QA + head * 128;
      attn_body<0, 0>(Q, U, C_KA + (head >> 2) * 128, C_VA + (head >> 2) * 128, Tlast + 1, 0, 0, Tlast, 16 * s, RB + R.S * s, 0, 0, 0, 0, 0.f, dry ? 0 : 256, nullptr, lds, swid);
      continue;
    }
    k -= nreal;
    int meta, s, head, qb;
    if (k < nreal) { meta = 0; s = k / per_seq; const int rem = k - s * per_seq; head = rem / NQB; qb = rem - head * NQB; }
    else { meta = 1; k -= nreal; s = k >> 3; head = k & 7; qb = 0; }
    const f16* Q = U + (size_t)(meta ? 16 * s : RB + R.S * s + qb * 256) * INW + C_QB + head * 128;
    const float sink = a.sink[l * 8 + head];
    attn_body<1, 0>(Q, U, C_KB + (head >> 2) * 128, C_VB + (head >> 2) * 128, meta ? 4 : 10, 0, meta ? 0 : qb * 4 - 2, Tlast, 16 * s, RB + R.S * s,
                    qb * 256, meta ? (1 << 24) : 128, meta ? 112 : 128, R.S - 1, sink, dry ? 0 : (meta ? 16 : 256), nullptr, lds, swid);
  }
}
__device__ __forceinline__ void phase_combine(const Args& a, const Round& R, int swid) {
  f16* U = (f16*)(a.ws + WS_U); const float* PART = (const float*)(a.ws + WS_PART);
  const int Tlast = R.S / 64 + 1, nchunk = (Tlast + 1) / CHUNK_T;
  const int tid_ = opaque_tid(swid); const int wid = tid_ >> 6, lane = tid_ & 63;
  constexpr float C = ASCALE * 1.4426950408889634f;
  for (int it = blockIdx.x * 8 + wid; it < R.nseq * 8 * 16; it += gridDim.x * 8) {
    const int u = it >> 4, m = it & 15, s = u >> 3, head = u & 7;
    const float* p0 = PART + (size_t)u * nchunk * PART_FLOATS;
    float mx = -1e30f;
    for (int c = 0; c < nchunk; ++c) mx = fmaxf(mx, p0[(size_t)c * PART_FLOATS + 2048 + m]);
    float wsum = 0.f, o0 = 0.f, o1 = 0.f;
    for (int c = 0; c < nchunk; ++c) { const float* p = p0 + (size_t)c * PART_FLOATS;
      const float w = p[2064 + m] * __builtin_amdgcn_exp2f((p[2048 + m] - mx) * C);
      wsum += w; o0 += w * p[m * 128 + lane]; o1 += w * p[m * 128 + 64 + lane]; }
    const float rw = 1.0f / wsum;
    f16* dst = U + (size_t)(16 * s + m) * INW + C_QA + head * 128;
    dst[lane] = (f16)(o0 * rw); dst[64 + lane] = (f16)(o1 * rw);
  }
}

#ifndef PROBE
#define PROBE 0
#endif
#define RELAUNDER() do { } while (0)
__global__ void __launch_bounds__(NTHR, 2) mega(Args a) {
  extern __shared__ __attribute__((aligned(16))) unsigned char lds[];
  cg::grid_group grid = cg::this_grid();
  const int swid = __builtin_amdgcn_readfirstlane((int)(threadIdx.x >> 6));
  volatile LAS unsigned* bst = (volatile LAS unsigned*)((LAS unsigned char*)lds + 131072 + 64);
  if (threadIdx.x < 2) bst[threadIdx.x] = 0u;
  __syncthreads();
  const XcdBarrier xbar = xcd_barrier_post((unsigned*)(a.ws + WS_BAR), bst, (int)threadIdx.x);
  phase_weights(a, (float*)lds, swid);
  { const Round R0 = get_round(0); phase_rows(a, R0, 0, nullptr, nullptr, 0, swid); }
  grid.sync();
  LAS unsigned char* ldsl = (LAS unsigned char*)lds;
  for (int r = 0; r < 4; ++r) {
    const Round R = get_round(r);
    const int nM = 64;
    for (int l = 0; l < 2; ++l) {
      RELAUNDER();
      meta_gemm<1>(a, l, (float*)lds, swid);
      { Sched<1> S{a.ws, l, nM, (int)gridDim.x, (int)blockIdx.x}; EpiU E{0, a.ws}; gemm_phase<DM * 2, DM * 2, 16>(ldsl, S, E, swid);
        if (PROBE == 1) gemm_phase<DM * 2, DM * 2, 16>(ldsl, S, E, swid); }
      xcd_barrier(xbar, swid); RELAUNDER();
      phase_prep(a, R, l, 0, swid);
      if (PROBE == 3) phase_prep(a, R, l, a.dry_on, swid);
      xcd_barrier(xbar, swid); RELAUNDER();
      phase_attn(a, R, l, (unsigned*)(a.ws + WS_CTL) + (r * 2 + l) * 64, (char*)lds, 0, swid);
      if (PROBE == 2) phase_attn(a, R, l, (unsigned*)(a.ws + WS_CTL) + (r * 2 + l) * 64 + 32, (char*)lds, a.dry_on, swid);
      xcd_barrier(xbar, swid); RELAUNDER();
      if (SPLITKV && l == 0) { phase_combine(a, R, swid); xcd_barrier(xbar, swid); RELAUNDER(); }
      meta_gemm<4>(a, l, (float*)lds, swid);
      for (int rep = 0; rep < (PROBE == 1 ? 2 : 1); ++rep) {
      { Sched<40> S{a.ws, l, nM, (int)gridDim.x, (int)blockIdx.x}; EpiGate<0> E{0, a.ws}; gemm_phase<INW * 2, DM * 2, 16>(ldsl, S, E, swid); }
      { Sched<41> S{a.ws, l, nM, (int)gridDim.x, (int)blockIdx.x}; EpiGate<1> E{0, a.ws}; gemm_phase<INW * 2, DM * 2, 16>(ldsl, S, E, swid); }
      { Sched<42> S{a.ws, l, nM, (int)gridDim.x, (int)blockIdx.x}; EpiGate<2> E{0, a.ws}; gemm_phase<DM * 2, 256 * 2, 4>(ldsl, S, E, swid); }
      }
      xcd_barrier(xbar, swid); RELAUNDER();
      meta_gemm<5>(a, l, (float*)lds, swid);
      { Sched<5> S{a.ws, l, nM, (int)gridDim.x, (int)blockIdx.x}; EpiResid E{0, a.ws}; gemm_phase<DM * 2, DM * 2, 16>(ldsl, S, E, swid);
        if (PROBE == 1) { E.dry = a.dry_on; gemm_phase<DM * 2, DM * 2, 16>(ldsl, S, E, swid); } }
      xcd_barrier(xbar, swid); RELAUNDER();
      phase_rows(a, R, 1, a.ln1g + l * DM, a.ln1b + l * DM, -1, swid);
      if (PROBE == 3) phase_rows(a, R, 1, a.ln1g + l * DM, a.ln1b + l * DM, -1, swid, a.dry_on);
      xcd_barrier(xbar, swid); RELAUNDER();
      meta_gemm<7>(a, l, (float*)lds, swid);
      { Sched<7> S{a.ws, l, nM, (int)gridDim.x, (int)blockIdx.x}; EpiSwiglu E{0, a.ws}; gemm_phase<DM * 2, DM * 2, 16>(ldsl, S, E, swid);
        if (PROBE == 1) gemm_phase<DM * 2, DM * 2, 16>(ldsl, S, E, swid); }
      xcd_barrier(xbar, swid); RELAUNDER();
      meta_gemm<8>(a, l, (float*)lds, swid);
      { Sched<8> S{a.ws, l, nM, (int)gridDim.x, (int)blockIdx.x}; EpiResid E{0, a.ws}; gemm_phase<DFF * 2, DFF * 2, 44>(ldsl, S, E, swid);
        if (PROBE == 1) { E.dry = a.dry_on; gemm_phase<DFF * 2, DFF * 2, 44>(ldsl, S, E, swid); } }
      xcd_barrier(xbar, swid); RELAUNDER();
      if (PROBE == 3) phase_rows(a, R, 1, a.ln2g + l * DM, a.ln2b + l * DM, -1, swid, a.dry_on);
      if (l == 0) phase_rows(a, R, 1, a.ln2g + l * DM, a.ln2b + l * DM, -1, swid);
      else phase_rows(a, R, 2, a.ln2g + l * DM, a.ln2b + l * DM, r < 3 ? r + 1 : -1, swid);
      xcd_barrier(xbar, swid); RELAUNDER();
    }
  }
}

extern "C" void kernel_launch(void* const* d_in, const int* in_sizes, int n_in, void* d_out, int out_size, void* d_ws, size_t ws_size, hipStream_t stream) {
  static int grid_blocks = 0;
  if (grid_blocks == 0) {
    if (n_in != 18 || ws_size < WS_END) { fprintf(stderr, "kernel_launch: n_in %d ws %zu (need %zu)\n", n_in, ws_size, (size_t)WS_END); grid_blocks = -1; return; }
    int dev = 0, cus = 0, per_cu = 0;
    hipGetDevice(&dev);
    hipDeviceGetAttribute(&cus, hipDeviceAttributeMultiprocessorCount, dev);
    if (hipFuncSetAttribute((const void*)mega, hipFuncAttributeMaxDynamicSharedMemorySize, LDS_BYTES) != hipSuccess) { fprintf(stderr, "kernel_launch: hipFuncSetAttribute failed\n"); grid_blocks = -1; return; }
    hipOccupancyMaxActiveBlocksPerMultiprocessor(&per_cu, (const void*)mega, NTHR, LDS_BYTES);
    if (per_cu < 1) { fprintf(stderr, "kernel_launch: occupancy query gave %d\n", per_cu); per_cu = 1; }
    if (per_cu > 1) per_cu = 1;
    grid_blocks = cus * per_cu;
  }
  if (grid_blocks < 0) return;
  (void)hipMemsetAsync((char*)d_ws + WS_CTL, 0, CTL_BYTES, stream);
  Args a{};
  a.x_prompt = (const float*)d_in[0]; a.x_sample = (const float*)d_in[1]; a.meta = (const float*)d_in[2]; a.w_in = (const float*)d_in[3];
  a.qg = (const float*)d_in[4]; a.kg = (const float*)d_in[5]; a.sink = (const float*)d_in[6]; a.pool_w = (const float*)d_in[7]; a.pool_scale = (const float*)d_in[8];
  a.w_a = (const float*)d_in[9]; a.w_b = (const float*)d_in[10]; a.w_out = (const float*)d_in[11]; a.ln1g = (const float*)d_in[12]; a.ln1b = (const float*)d_in[13];
  a.w_up = (const float*)d_in[14]; a.w_down = (const float*)d_in[15]; a.ln2g = (const float*)d_in[16]; a.ln2b = (const float*)d_in[17];
  a.out = (float*)d_out; a.ws = (unsigned char*)d_ws; a.dry_on = 1; a.pad = 0;
  void* args[] = {&a};
  hipError_t e = hipLaunchCooperativeKernel((const void*)mega, dim3(grid_blocks), dim3(NTHR), args, LDS_BYTES, stream);
  if (e != hipSuccess) fprintf(stderr, "cooperative launch failed: %s (grid %d)\n", hipGetErrorString(e), grid_blocks);
}
```
